# Optimizing an MI355X kernel written in HIP

```python
import math
import jax, jax.numpy as jnp
from jax import lax
import numpy as np

D_MODEL = 2048
BATCH = 32
SEQ = 256
DEPTH = 4
DEC_BATCH = 2
DEC_SEQ = 2048
PAST_LEN = 512

GRID_W = 64
HEAD_DIM = 128
N_HEADS = 8
N_KV_HEADS = 2
KV_GROUP = N_HEADS // N_KV_HEADS
D_ATTN = N_HEADS * HEAD_DIM
D_KV = N_KV_HEADS * HEAD_DIM
WINDOW = 128
Q_BLOCK = 128
ROPE_THETA = 10000.0
D_LRU = D_MODEL // 4
LRU_BLOCKS = 4
LRU_BLK = D_LRU // LRU_BLOCKS
CONV_W = 4
CONV_LEFT = 2
LRU_C = 8.0
D_POOL = D_MODEL // 4
POOL_WINDOWS = (2, 4, 8, 16)
N_POOL_GROUPS = len(POOL_WINDOWS)
POOL_GROUP = D_POOL // N_POOL_GROUPS
D_MIX = D_ATTN + D_LRU + D_POOL
D_IN = D_ATTN + 2 * D_KV + 2 * D_LRU + D_POOL
SPLITS = (D_ATTN, D_ATTN + D_KV, D_ATTN + 2 * D_KV, D_ATTN + 2 * D_KV + D_LRU, D_ATTN + 2 * D_KV + 2 * D_LRU)
D_FF = -(-(8 * D_MODEL) // (3 * 256)) * 256
N_MOD = 6
RMS_EPS = 1e-6
MOD_INIT = 0.5
NEG_INF = -1e30

kernel_name = 'hymba_diffusion_prefix_step'


def _rmsnorm(x, g):
    xf = x.astype(jnp.float32)
    y = xf * lax.rsqrt(jnp.mean(xf * xf, axis=-1, keepdims=True) + RMS_EPS)
    return (y * g.astype(jnp.float32)).astype(x.dtype)


def _mod_vectors(cond, w, b):
    m = jax.nn.silu(cond) @ w + b
    m = m.reshape(cond.shape[0], N_MOD, D_MODEL)
    return jnp.moveaxis(m, 1, 0)[:, :, None, :]


def _rope_2d_tables(T, dtype):
    rows = T // GRID_W
    row = jnp.repeat(jnp.arange(rows), GRID_W)
    col = jnp.tile(jnp.arange(GRID_W), rows)
    pos = jnp.stack([row, col], axis=-1).astype(jnp.float32)
    rd = HEAD_DIM // 4
    inv = ROPE_THETA ** (-jnp.arange(rd, dtype=jnp.float32) / rd)
    ang = jnp.broadcast_to(pos[:, :, None, None] * inv, (T, 2, 2, rd)).reshape(T, HEAD_DIM)
    return jnp.cos(ang).astype(dtype), jnp.sin(ang).astype(dtype)


def _apply_rope(x, cos, sin):
    xr = x.reshape(x.shape[:-1] + (2, 2, HEAD_DIM // 4))
    rot = jnp.stack([-xr[..., 1, :], xr[..., 0, :]], axis=-2).reshape(x.shape)
    return x * cos[None, :, None, :] + rot * sin[None, :, None, :]


def _attend(q, k, v, bias, sink):
    s = jnp.einsum('bqkgd,bskd->bkgqs', q, k).astype(jnp.float32) * (HEAD_DIM ** -0.5) + bias
    B, Q = q.shape[0], q.shape[1]
    sink_col = jnp.broadcast_to(sink.astype(jnp.float32)[None, :, :, None, None], (B, N_KV_HEADS, KV_GROUP, Q, 1))
    p = jax.nn.softmax(jnp.concatenate([s, sink_col], axis=-1), axis=-1)[..., :-1]
    return jnp.einsum('bkgqs,bskd->bqkgd', p.astype(v.dtype), v)


def _context_attention(q, k, v, sink):
    B, C = q.shape[:2]
    bias = jnp.zeros((Q_BLOCK, C), jnp.float32)

    def blk(i):
        qb = lax.dynamic_slice_in_dim(q, i * Q_BLOCK, Q_BLOCK, axis=1)
        return _attend(qb, k, v, bias, sink)

    o = lax.map(blk, jnp.arange(C // Q_BLOCK))
    return jnp.moveaxis(o, 0, 1).reshape(B, C, D_ATTN)


def _latent_attention(q, k, v, ctx_k, ctx_v, sink):
    B, T = q.shape[:2]
    C = ctx_k.shape[1]
    band = Q_BLOCK + 2 * WINDOW
    kp = jnp.pad(k, ((0, 0), (WINDOW, WINDOW), (0, 0), (0, 0)))
    vp = jnp.pad(v, ((0, 0), (WINDOW, WINDOW), (0, 0), (0, 0)))
    rel = jnp.arange(Q_BLOCK)[:, None] - jnp.arange(band)[None, :] + WINDOW
    ctx_bias = jnp.zeros((Q_BLOCK, C), jnp.float32)

    def blk(i):
        start = i * Q_BLOCK
        qb = lax.dynamic_slice_in_dim(q, start, Q_BLOCK, axis=1)
        kb = lax.dynamic_slice_in_dim(kp, start, band, axis=1)
        vb = lax.dynamic_slice_in_dim(vp, start, band, axis=1)
        kpos = start - WINDOW + jnp.arange(band)
        valid = (jnp.abs(rel) <= WINDOW) & ((kpos >= 0) & (kpos < T))[None, :]
        bias = jnp.concatenate([jnp.where(valid, 0.0, NEG_INF).astype(jnp.float32), ctx_bias], axis=1)
        return _attend(qb, jnp.concatenate([kb, ctx_k], axis=1), jnp.concatenate([vb, ctx_v], axis=1), bias, sink)

    o = lax.map(blk, jnp.arange(T // Q_BLOCK))
    return jnp.moveaxis(o, 0, 1).reshape(B, T, D_ATTN)


def _dwconv(u, w, b):
    T = u.shape[1]
    up = jnp.pad(u, ((0, 0), (CONV_LEFT, CONV_W - 1 - CONV_LEFT), (0, 0)))
    return sum(up[:, j:j + T] * w[j] for j in range(CONV_W)) + b


def _lin_combine(left, right):
    a1, b1 = left
    a2, b2 = right
    return a1 * a2, a2 * b1 + b2


def _rglru_bidir(u, wa, ba, wx, bx, lam, h0):
    B, T, _ = u.shape
    ub = u.reshape(B, T, LRU_BLOCKS, LRU_BLK)
    uf = u.astype(jnp.float32)
    y = jnp.zeros((B, T, D_LRU), jnp.float32)
    finals = []
    for d in range(2):
        r = jax.nn.sigmoid((jnp.einsum('btnc,ncd->btnd', ub, wa[d]).reshape(B, T, D_LRU) + ba[d]).astype(jnp.float32))
        ig = jax.nn.sigmoid((jnp.einsum('btnc,ncd->btnd', ub, wx[d]).reshape(B, T, D_LRU) + bx[d]).astype(jnp.float32))
        log_a = LRU_C * r * jax.nn.log_sigmoid(lam[d].astype(jnp.float32))
        a = jnp.exp(log_a)
        bterm = jnp.sqrt(-jnp.expm1(2.0 * log_a)) * ig * uf
        if d == 1:
            a, bterm = a[:, ::-1], bterm[:, ::-1]
        a_cum, b_cum = lax.associative_scan(_lin_combine, (a, bterm), axis=1)
        h = a_cum * h0[:, d, None, :].astype(jnp.float32) + b_cum
        finals.append(h[:, -1])
        if d == 1:
            h = h[:, ::-1]
        y = y + h
    return y.astype(u.dtype), jnp.stack(finals, axis=1).astype(u.dtype)


def _pool_mixer(u, w, scale):
    B, T, _ = u.shape
    ug = u.reshape(B, T, N_POOL_GROUPS, POOL_GROUP).astype(jnp.float32)
    cs = jnp.pad(jnp.cumsum(ug, axis=1), ((0, 0), (1, 0), (0, 0), (0, 0)))
    t = jnp.arange(T)
    groups = []
    for g, win in enumerate(POOL_WINDOWS):
        lo = jnp.clip(t - win // 2, 0, T)
        hi = jnp.clip(t + win // 2, 0, T)
        cs_g = cs[:, :, g]
        mean = (cs_g[:, hi] - cs_g[:, lo]) / (hi - lo).astype(jnp.float32)[None, :, None]
        groups.append(mean - ug[:, :, g])
    pooled = jnp.stack(groups, axis=2).astype(u.dtype)
    y = jnp.einsum('btgc,gcd->btgd', pooled, w).reshape(B, T, D_POOL)
    return y * scale


def _mixer_inputs(x, mod, p):
    h = _rmsnorm(x, p['norm_mix']) * (1 + mod[1]) + mod[0]
    return jnp.split(h @ p['w_in'], SPLITS, axis=-1)


def _layer_tail(x, mod, attn, lru_h, lg, pool, p):
    mix = jnp.concatenate([attn, lru_h * jax.nn.gelu(lg), pool], axis=-1) @ p['w_out']
    x = x + mod[2] * mix
    h = _rmsnorm(x, p['norm_ffn']) * (1 + mod[4]) + mod[3]
    ga, up = jnp.split(h @ p['ffn_w1'], 2, axis=-1)
    return x + mod[5] * ((jax.nn.silu(ga) * up) @ p['ffn_w2'])


def _context_layer(x, mod, p):
    B, C, _ = x.shape
    q, k, v, lx, lg, pu = _mixer_inputs(x, mod, p)
    q = q.reshape(B, C, N_KV_HEADS, KV_GROUP, HEAD_DIM)
    k = k.reshape(B, C, N_KV_HEADS, HEAD_DIM)
    v = v.reshape(B, C, N_KV_HEADS, HEAD_DIM)
    attn = _context_attention(q, k, v, p['sink'])
    u = _dwconv(lx, p['conv_w'], p['conv_b'])
    h0 = jnp.zeros((B, 2, D_LRU), x.dtype)
    lru_h, h_fin = _rglru_bidir(u, p['lru_wa'], p['lru_ba'], p['lru_wx'], p['lru_bx'], p['lru_lambda'], h0)
    pool = _pool_mixer(pu, p['pool_w'], p['pool_scale'])
    return _layer_tail(x, mod, attn, lru_h, lg, pool, p), k, v, h_fin


def _latent_layer(x, mod, ctx_k, ctx_v, ctx_h, p):
    B, T, _ = x.shape
    q, k, v, lx, lg, pu = _mixer_inputs(x, mod, p)
    cos, sin = _rope_2d_tables(T, x.dtype)
    q = _apply_rope(q.reshape(B, T, N_HEADS, HEAD_DIM), cos, sin).reshape(B, T, N_KV_HEADS, KV_GROUP, HEAD_DIM)
    k = _apply_rope(k.reshape(B, T, N_KV_HEADS, HEAD_DIM), cos, sin)
    v = v.reshape(B, T, N_KV_HEADS, HEAD_DIM)
    attn = _latent_attention(q, k, v, ctx_k, ctx_v, p['sink'])
    u = _dwconv(lx, p['conv_w'], p['conv_b'])
    lru_h, _ = _rglru_bidir(u, p['lru_wa'], p['lru_ba'], p['lru_wx'], p['lru_bx'], p['lru_lambda'], ctx_h)
    pool = _pool_mixer(pu, p['pool_w'], p['pool_scale'])
    return _layer_tail(x, mod, attn, lru_h, lg, pool, p)


def setup_inputs(seed: int = 0) -> dict:
    key = jax.random.key(seed)
    ks = jax.random.split(key, 32)
    f32 = jnp.float32

    def nrm(k, shape, s):
        return jax.random.normal(k, shape, f32) * s

    a_c = jax.random.uniform(ks[19], (DEPTH, 2, D_LRU), f32, 0.9, 0.999)
    sig = a_c ** (1.0 / LRU_C)
    return {
        'x_prompt': nrm(ks[0], (BATCH, SEQ, D_MODEL), 1.0),
        'x_sample': nrm(ks[1], (DEC_BATCH, DEC_SEQ, D_MODEL), 1.0),
        'cache_k': nrm(ks[2], (DEC_BATCH, DEPTH, PAST_LEN, N_KV_HEADS, HEAD_DIM), 1.0),
        'cache_v': nrm(ks[3], (DEC_BATCH, DEPTH, PAST_LEN, N_KV_HEADS, HEAD_DIM), 1.0),
        'state_lru': nrm(ks[4], (DEC_BATCH, DEPTH, 2, D_LRU), 0.5),
        'c': nrm(ks[5], (DEC_BATCH, D_MODEL), 1.0),
        'c_ctx': nrm(ks[6], (D_MODEL,), 1.0),
        'mod_w': nrm(ks[7], (DEPTH, D_MODEL, N_MOD * D_MODEL), MOD_INIT * D_MODEL ** -0.5),
        'mod_b': nrm(ks[8], (DEPTH, N_MOD * D_MODEL), 0.02),
        'norm_mix': 1.0 + nrm(ks[9], (DEPTH, D_MODEL), 0.02),
        'norm_ffn': 1.0 + nrm(ks[10], (DEPTH, D_MODEL), 0.02),
        'w_in': nrm(ks[11], (DEPTH, D_MODEL, D_IN), D_MODEL ** -0.5),
        'attn_sink': nrm(ks[12], (DEPTH, N_HEADS), 0.5),
        'conv_w': nrm(ks[13], (DEPTH, CONV_W, D_LRU), CONV_W ** -0.5),
        'conv_b': nrm(ks[14], (DEPTH, D_LRU), 0.02),
        'lru_wa': nrm(ks[15], (DEPTH, 2, LRU_BLOCKS, LRU_BLK, LRU_BLK), LRU_BLK ** -0.5),
        'lru_ba': nrm(ks[16], (DEPTH, 2, D_LRU), 0.02),
        'lru_wx': nrm(ks[17], (DEPTH, 2, LRU_BLOCKS, LRU_BLK, LRU_BLK), LRU_BLK ** -0.5),
        'lru_bx': nrm(ks[18], (DEPTH, 2, D_LRU), 0.02),
        'lru_lambda': jnp.log(sig) - jnp.log1p(-sig),
        'pool_w': nrm(ks[20], (DEPTH, N_POOL_GROUPS, POOL_GROUP, POOL_GROUP), POOL_GROUP ** -0.5),
        'pool_scale': 1.0 + nrm(ks[21], (DEPTH, D_POOL), 0.02),
        'w_out': nrm(ks[22], (DEPTH, D_MIX, D_MODEL), D_MIX ** -0.5),
        'ffn_w1': nrm(ks[23], (DEPTH, D_MODEL, 2 * D_FF), D_MODEL ** -0.5),
        'ffn_w2': nrm(ks[24], (DEPTH, D_FF, D_MODEL), D_FF ** -0.5),
        'norm_final': 1.0 + nrm(ks[25], (D_MODEL,), 0.02),
    }


def reference(x_prompt, x_sample, cache_k, cache_v, state_lru, c, c_ctx, mod_w, mod_b, norm_mix, norm_ffn, w_in, attn_sink, conv_w, conv_b, lru_wa, lru_ba, lru_wx, lru_bx, lru_lambda, pool_w, pool_scale, w_out, ffn_w1, ffn_w2, norm_final):
    xp = x_prompt
    xs = x_sample
    ks_new, vs_new, hs_new = [], [], []
    for l in range(DEPTH):
        p = {
            'norm_mix': norm_mix[l], 'norm_ffn': norm_ffn[l], 'w_in': w_in[l],
            'sink': attn_sink[l].reshape(N_KV_HEADS, KV_GROUP),
            'conv_w': conv_w[l], 'conv_b': conv_b[l],
            'lru_wa': lru_wa[l], 'lru_ba': lru_ba[l], 'lru_wx': lru_wx[l], 'lru_bx': lru_bx[l],
            'lru_lambda': lru_lambda[l], 'pool_w': pool_w[l], 'pool_scale': pool_scale[l],
            'w_out': w_out[l], 'ffn_w1': ffn_w1[l], 'ffn_w2': ffn_w2[l],
        }
        mod_ctx = _mod_vectors(c_ctx[None, :], mod_w[l], mod_b[l])
        xp, k_l, v_l, h_l = _context_layer(xp, mod_ctx, p)
        ks_new.append(k_l)
        vs_new.append(v_l)
        hs_new.append(h_l)
        mod_lat = _mod_vectors(c, mod_w[l], mod_b[l])
        xs = _latent_layer(xs, mod_lat, cache_k[:, l], cache_v[:, l], state_lru[:, l], p)
    y_prompt = _rmsnorm(xp, norm_final)
    y_sample = _rmsnorm(xs, norm_final)
    new_cache_k = jnp.stack(ks_new, axis=1)
    new_cache_v = jnp.stack(vs_new, axis=1)
    new_state_lru = jnp.stack(hs_new, axis=1)
    return (y_prompt, y_sample, new_cache_k, new_cache_v, new_state_lru)
```

```cpp
#include <hip/hip_runtime.h>
#include <cstdio>
#include <cstdint>
namespace pg8 {
#define PG8_LAS __attribute__((address_space(3)))
typedef unsigned short bf16_t;
typedef short bf16x8 __attribute__((ext_vector_type(8)));
typedef float f32x4 __attribute__((ext_vector_type(4)));
typedef unsigned u32x4 __attribute__((ext_vector_type(4)));
constexpr int BM = 256, BK = 64, HALF = 128, HTB = HALF * BK * 2  , STAGE_BYTES = 8 * HTB, NXCD = 8, WGM = 8;

__host__ __device__ __forceinline__ int lds_byte(int r, int c) { const int st = (r >> 4) * 2 + (c >> 5), rr = r & 15, cc = c & 31, ob = rr * 64 + cc * 2; return st * 1024 + (ob ^ (((ob >> 9) & 1) << 5)); }
__host__ __device__ __forceinline__ void stage_rc(int b, int& R, int& C) { const int st = b / 1024, sb = b % 1024, swz = sb ^ (((sb >> 9) & 1) << 5); R = (st >> 1) * 16 + swz / 64; C = (st & 1) * 32 + (swz % 64) / 2; }
__host__ __device__ __forceinline__ int perm32(int rho) { const int n = rho >> 4, i = rho & 15; return 8 * (i >> 2) + 4 * n + (i & 3); }

struct Unit { int pm, pn; };
struct Gemm { const bf16_t* A; const bf16_t* Bt; int M, N, K; };

struct StaticOrder {
    int nM, nN, nwg, G, c;
    __host__ __device__ void init(int M, int N, int G_, int c_) { nM = M / BM; nN = N / BM; nwg = nM * nN; G = G_; c = c_; }
    __host__ __device__ bool next(int i, Unit& u) const {
        const long L = (long)i * G + c; if (L >= nwg) return false;
        int wgid = (int)L; { const int q = nwg / NXCD, r = nwg % NXCD, xcd = wgid % NXCD, off = wgid / NXCD; wgid = (xcd < r ? xcd * (q + 1) : r * (q + 1) + (xcd - r) * q) + off; }
        const int nig = WGM * nN, gid = wgid / nig, fm = gid * WGM, gsz = (nM - fm) < WGM ? (nM - fm) : WGM;
        u.pm = fm + ((wgid % nig) % gsz); u.pn = (wgid % nig) / gsz; return true;
    }
    __device__ __forceinline__ void a_ready(const Unit&) const {}
    __device__ __forceinline__ void done(const Unit&) const {}
};
__device__ __forceinline__ unsigned cvt_pk_bf16(float lo, float hi) { unsigned r; asm volatile("v_cvt_pk_bf16_f32 %0, %1, %2" : "=v"(r) : "v"(lo), "v"(hi)); return r; }
typedef float f32x2 __attribute__((ext_vector_type(2)));
struct EpiIn {
    static constexpr bool PERM = true, AFTER_DRAIN = false;
    bf16_t* P; float* outk; float* outv; const float* rcs; const float* rsn; int layer;
    __device__ __forceinline__ void operator()(const f32x4 (&acc)[2][2][4][2], const Unit& u, int wr, int wc, int fr, int fq) const {
        const bool lat = u.pm >= 32; const bool rope = lat && (u.pn <= 4); const bool kout = (!lat) && (u.pn == 4), vout = (!lat) && (u.pn == 5);
        const int i0 = (wc & 1) * 16 + 4 * fq;
#pragma unroll
        for (int ai = 0; ai < 2; ++ai)
#pragma unroll
            for (int m = 0; m < 4; ++m) {
                const int row = u.pm * BM + ai * HALF + wr * 64 + m * 16 + fr;
                f32x4 cs4 = (f32x4){1.f, 1.f, 1.f, 1.f}, sn4 = (f32x4){0.f, 0.f, 0.f, 0.f};
                if (rope) { const int t = (row - 8192) & 2047; const int p = (wc >> 1) ? (t & 63) : (t >> 6); cs4 = *(const f32x4*)(rcs + p * 32 + i0); sn4 = *(const f32x4*)(rsn + p * 32 + i0); }
#pragma unroll
                for (int bj = 0; bj < 2; ++bj) {
                    f32x4 v0 = acc[ai][bj][m][0], v1 = acc[ai][bj][m][1];
                    if (kout) { float* d = outk + ((size_t)(((row >> 8) * 4 + layer) * 256 + (row & 255)) * 256 + bj * 128 + (wc >> 1) * 64 + (wc & 1) * 16 + 4 * fq);
                        *(f32x4*)d = (f32x4){v0[0], v0[2], v1[0], v1[2]}; *(f32x4*)(d + 32) = (f32x4){v0[1], v0[3], v1[1], v1[3]}; }
                    if (vout) { float* d = outv + ((size_t)(((row >> 8) * 4 + layer) * 256 + (row & 255)) * 256 + bj * 128 + wc * 32 + 8 * fq); *(f32x4*)d = v0; *(f32x4*)(d + 4) = v1; }
                    if (rope) {
                        const f32x4 a0 = v0, a1 = v1;
                        v0[0] = a0[0] * cs4[0] - a0[1] * sn4[0]; v0[1] = a0[1] * cs4[0] + a0[0] * sn4[0];
                        v0[2] = a0[2] * cs4[1] - a0[3] * sn4[1]; v0[3] = a0[3] * cs4[1] + a0[2] * sn4[1];
                        v1[0] = a1[0] * cs4[2] - a1[1] * sn4[2]; v1[1] = a1[1] * cs4[2] + a1[0] * sn4[2];
                        v1[2] = a1[2] * cs4[3] - a1[3] * sn4[3]; v1[3] = a1[3] * cs4[3] + a1[2] * sn4[3];
                    }
                    u32x4 w; w.x = cvt_pk_bf16(v0[0], v0[1]); w.y = cvt_pk_bf16(v0[2], v0[3]); w.z = cvt_pk_bf16(v1[0], v1[1]); w.w = cvt_pk_bf16(v1[2], v1[3]);
                    *(u32x4*)(P + (size_t)row * 3072 + u.pn * BM + bj * HALF + wc * 32 + 8 * fq) = w;
                }
            }
    }
};
struct EpiRes {
    static constexpr bool PERM = false, AFTER_DRAIN = false;
    const float* bctx; const float* blat; float* out; const float* gate;
    __device__ __forceinline__ void operator()(const f32x4 (&acc)[2][2][4][2], const Unit& u, int wr, int wc, int fr, int fq) const {
        const int cond = u.pm < 32 ? 0 : (u.pm < 40 ? 1 : 2);
        const float* g = gate + cond * 12288; const float* bs = u.pm < 32 ? bctx : blat - (size_t)8192 * 2048;
        const int col0 = u.pn * BM + wc * 32 + 4 * fq;
        f32x4 gv[2][2];
#pragma unroll
        for (int bj = 0; bj < 2; ++bj)
#pragma unroll
            for (int n = 0; n < 2; ++n) gv[bj][n] = *(const f32x4*)(g + col0 + bj * HALF + n * 16);
#pragma unroll
        for (int ai = 0; ai < 2; ++ai)
#pragma unroll
            for (int m = 0; m < 4; ++m) { const size_t off = (size_t)(u.pm * BM + ai * HALF + wr * 64 + m * 16 + fr) * 2048 + col0;
#pragma unroll
                for (int bj = 0; bj < 2; ++bj)
#pragma unroll
                    for (int n = 0; n < 2; ++n) { const f32x4 b = *(const f32x4*)(bs + off + bj * HALF + n * 16); *(f32x4*)(out + off + bj * HALF + n * 16) = b + gv[bj][n] * acc[ai][bj][m][n]; }
            }
    }
};
struct EpiSwiGLU {
    static constexpr bool PERM = true, AFTER_DRAIN = false;
    bf16_t* act;
    __device__ __forceinline__ float sl(float g, float u) const { return g * u * __builtin_amdgcn_rcpf(1.0f + __builtin_amdgcn_exp2f(-1.4426950408889634f * g)); }
    __device__ __forceinline__ void operator()(const f32x4 (&acc)[2][2][4][2], const Unit& u, int wr, int wc, int fr, int fq) const {
#pragma unroll
        for (int ai = 0; ai < 2; ++ai)
#pragma unroll
            for (int m = 0; m < 4; ++m) { const int row = u.pm * BM + ai * HALF + wr * 64 + m * 16 + fr;
                const f32x4 g0 = acc[ai][0][m][0], g1 = acc[ai][0][m][1], u0 = acc[ai][1][m][0], u1 = acc[ai][1][m][1];
                u32x4 w; w.x = cvt_pk_bf16(sl(g0[0], u0[0]), sl(g0[1], u0[1])); w.y = cvt_pk_bf16(sl(g0[2], u0[2]), sl(g0[3], u0[3]));
                w.z = cvt_pk_bf16(sl(g1[0], u1[0]), sl(g1[1], u1[1])); w.w = cvt_pk_bf16(sl(g1[2], u1[2]), sl(g1[3], u1[3]));
                *(u32x4*)(act + (size_t)row * 5632 + u.pn * HALF + wc * 32 + 8 * fq) = w; }
    }
};
template <class Epi, class Sched, bool ALIGN_EPI = false, bool SP2 = false>
__device__ __forceinline__ void gemm_phase(PG8_LAS unsigned char* lds, const Gemm g, const Sched& S, const Epi& E) {
    int tid_ = threadIdx.x; asm volatile("" : "+v"(tid_));
    const int tid = tid_, wid = __builtin_amdgcn_readfirstlane(tid >> 6), lane = tid & 63, wr = wid >> 2, wc = wid & 3, fr = lane & 15, fq = lane >> 4;
    const int K = g.K, nt = K / BK;
    unsigned voffA[2], voffB[2];
#pragma unroll
    for (int i = 0; i < 2; ++i) { int R, C; stage_rc(tid * 16 + i * 8192, R, C); const int Rb = Epi::PERM ? ((R & ~31) + perm32(R & 31)) : R;
        voffA[i] = (unsigned)(R * K + C) * 2u; voffB[i] = (unsigned)(Rb * K + C) * 2u; }
    const size_t kstep = (size_t)(BK * 2);
    const size_t hstep = (size_t)HALF * K * 2;
    const size_t tstep = 2 * hstep;
    const unsigned ldsw = (unsigned)wid * 1024u;
    const int aoff = lds_byte(wr * 64 + fr, fq * 8), boff = lds_byte(wc * 32 + fr, fq * 8);
#define PG8_SA(b, h) (((b) * 2 + (h)) * HTB)
#define PG8_SB(b, h) ((4 + (b) * 2 + (h)) * HTB)
#define PG8_STAGE(bufoff, gbase, voff) do { _Pragma("unroll") for (int _i = 0; _i < 2; ++_i) \
        __builtin_amdgcn_global_load_lds((const unsigned*)((const char*)(gbase) + (voff)[_i]), (PG8_LAS unsigned*)(lds + (bufoff) + ldsw + _i * 8192), 16, 0, 0); } while (0)
#define PG8_LDA(dst, b, h) do { _Pragma("unroll") for (int m = 0; m < 4; ++m) _Pragma("unroll") for (int k = 0; k < 2; ++k) dst[m][k] = *(const PG8_LAS bf16x8*)(lds + PG8_SA(b, h) + aoff + m * 2048 + k * 1024); } while (0)
#define PG8_LDB(dst, b, h) do { _Pragma("unroll") for (int n = 0; n < 2; ++n) _Pragma("unroll") for (int k = 0; k < 2; ++k) dst[n][k] = *(const PG8_LAS bf16x8*)(lds + PG8_SB(b, h) + boff + n * 2048 + k * 1024); } while (0)
#define PG8_MMA(ai, bj, At, Bt) do { __builtin_amdgcn_s_setprio(1); _Pragma("unroll") for (int m = 0; m < 4; ++m) _Pragma("unroll") for (int n = 0; n < 2; ++n) _Pragma("unroll") for (int k = 0; k < 2; ++k) \
        acc[ai][bj][m][n] = __builtin_amdgcn_mfma_f32_16x16x32_bf16(Bt[n][k], At[m][k], acc[ai][bj][m][n], 0, 0, 0); __builtin_amdgcn_s_setprio(0); } while (0)
#define PG8_WAIT_V(n) asm volatile("s_waitcnt vmcnt(" #n ")" ::: "memory")
#define PG8_WAIT_L(n) asm volatile("s_waitcnt lgkmcnt(" #n ")" ::: "memory")
#define PG8_BAR __builtin_amdgcn_s_barrier()
#define PG8_SCHED __builtin_amdgcn_sched_barrier(0)
    Unit cur, nxt; int ui = 0;
    if (!S.next(0, cur)) return;
    f32x4 acc[2][2][4][2];
#pragma unroll
    for (int a = 0; a < 2; ++a)
#pragma unroll
        for (int b = 0; b < 2; ++b)
#pragma unroll
            for (int m = 0; m < 4; ++m)
#pragma unroll
                for (int n = 0; n < 2; ++n) acc[a][b][m][n] = (f32x4){0.f, 0.f, 0.f, 0.f};
    bf16x8 At[4][2], B0[2][2], B1[2][2];
    const char* cA = (const char*)g.A + (size_t)cur.pm * tstep; const char* cB = (const char*)g.Bt + (size_t)cur.pn * tstep;
    S.a_ready(cur);
    if constexpr (SP2) {
        PG8_STAGE(PG8_SB(0, 0), cB, voffB); PG8_STAGE(PG8_SB(0, 1), cB + hstep, voffB); PG8_STAGE(PG8_SA(0, 0), cA, voffA); PG8_STAGE(PG8_SA(0, 1), cA + hstep, voffA);
        if (wr == 1) PG8_BAR;
        PG8_WAIT_V(2); PG8_BAR;
        PG8_STAGE(PG8_SB(1, 0), cB + kstep, voffB); PG8_STAGE(PG8_SA(1, 0), cA + kstep, voffA); PG8_STAGE(PG8_SB(1, 1), cB + hstep + kstep, voffB);
        PG8_WAIT_V(6); PG8_BAR;
    } else {
        PG8_STAGE(PG8_SB(0, 0), cB, voffB); PG8_STAGE(PG8_SA(0, 0), cA, voffA); PG8_STAGE(PG8_SB(0, 1), cB + hstep, voffB); PG8_STAGE(PG8_SA(0, 1), cA + hstep, voffA);
        if (wr == 1) PG8_BAR;
        PG8_WAIT_V(4); PG8_BAR;
        PG8_STAGE(PG8_SB(1, 0), cB + kstep, voffB); PG8_STAGE(PG8_SA(1, 0), cA + kstep, voffA); PG8_STAGE(PG8_SB(1, 1), cB + hstep + kstep, voffB);
        PG8_WAIT_V(6); PG8_BAR;
    }
    for (;;) {
        const bool has_next = S.next(ui + 1, nxt);
        const char* nA = has_next ? (const char*)g.A + (size_t)nxt.pm * tstep : cA; const char* nB = has_next ? (const char*)g.Bt + (size_t)nxt.pn * tstep : cB;
        for (int t = 0; t < nt; t += 2) {
            const bool last = (t == nt - 2);
            const char* a1 = cA + (size_t)(t + 1) * kstep;
            const char* a2 = last ? nA : cA + (size_t)(t + 2) * kstep; const char* b2 = last ? nB : cB + (size_t)(t + 2) * kstep;
            const char* a3 = a2 + kstep; const char* b3 = b2 + kstep;
            if (last && has_next) S.a_ready(nxt);
            if constexpr (SP2) {
            PG8_LDB(B0, 0, 0); PG8_LDB(B1, 0, 1); PG8_SCHED; PG8_LDA(At, 0, 0); PG8_STAGE(PG8_SA(1, 1), a1 + hstep, voffA);
            PG8_WAIT_V(8); PG8_WAIT_L(0); PG8_BAR; PG8_MMA(0, 0, At, B0); PG8_MMA(0, 1, At, B1); PG8_BAR; PG8_SCHED;
            PG8_LDA(At, 0, 1); PG8_STAGE(PG8_SB(0, 0), b2, voffB); PG8_STAGE(PG8_SB(0, 1), b2 + hstep, voffB); PG8_STAGE(PG8_SA(0, 0), a2, voffA);
            PG8_WAIT_V(8); PG8_WAIT_L(0); PG8_BAR; PG8_MMA(1, 0, At, B0); PG8_MMA(1, 1, At, B1); PG8_BAR; PG8_SCHED;
            PG8_LDB(B0, 1, 0); PG8_LDB(B1, 1, 1); PG8_SCHED; PG8_LDA(At, 1, 0); PG8_STAGE(PG8_SA(0, 1), a2 + hstep, voffA);
            PG8_WAIT_V(8); PG8_WAIT_L(0); PG8_BAR; PG8_MMA(0, 0, At, B0); PG8_MMA(0, 1, At, B1); PG8_BAR; PG8_SCHED;
            PG8_LDA(At, 1, 1); PG8_STAGE(PG8_SB(1, 0), b3, voffB); PG8_STAGE(PG8_SB(1, 1), b3 + hstep, voffB); PG8_STAGE(PG8_SA(1, 0), a3, voffA);
            PG8_WAIT_V(8); PG8_WAIT_L(0); PG8_BAR; PG8_MMA(1, 0, At, B0); PG8_MMA(1, 1, At, B1); PG8_BAR; PG8_SCHED;
            } else {
            PG8_LDB(B0, 0, 0); PG8_SCHED; PG8_LDA(At, 0, 0); PG8_STAGE(PG8_SA(1, 1), a1 + hstep, voffA);
            PG8_WAIT_L(8); PG8_BAR; PG8_WAIT_L(0); PG8_MMA(0, 0, At, B0); PG8_BAR; PG8_SCHED;
            PG8_LDB(B1, 0, 1); PG8_STAGE(PG8_SB(0, 0), b2, voffB);
            PG8_BAR; PG8_WAIT_L(0); PG8_MMA(0, 1, At, B1); PG8_BAR;
            PG8_LDA(At, 0, 1); PG8_STAGE(PG8_SA(0, 0), a2, voffA);
            PG8_BAR; PG8_WAIT_L(0); PG8_MMA(1, 0, At, B0); PG8_BAR; PG8_SCHED;
            PG8_STAGE(PG8_SB(0, 1), b2 + hstep, voffB);
            PG8_WAIT_V(6); PG8_BAR; PG8_MMA(1, 1, At, B1); PG8_BAR;
            PG8_LDB(B0, 1, 0); PG8_SCHED; PG8_LDA(At, 1, 0); PG8_STAGE(PG8_SA(0, 1), a2 + hstep, voffA);
            PG8_WAIT_L(8); PG8_BAR; PG8_WAIT_L(0); PG8_MMA(0, 0, At, B0); PG8_BAR; PG8_SCHED;
            PG8_LDB(B1, 1, 1); PG8_STAGE(PG8_SB(1, 0), b3, voffB);
            PG8_BAR; PG8_WAIT_L(0); PG8_MMA(0, 1, At, B1); PG8_BAR;
            PG8_LDA(At, 1, 1); PG8_STAGE(PG8_SA(1, 0), a3, voffA);
            PG8_BAR; PG8_WAIT_L(0); PG8_MMA(1, 0, At, B0); PG8_BAR; PG8_SCHED;
            PG8_STAGE(PG8_SB(1, 1), b3 + hstep, voffB);
            PG8_WAIT_V(6); PG8_BAR; PG8_MMA(1, 1, At, B1); PG8_BAR;
            }
        }
        if constexpr (ALIGN_EPI) { if (wr == 0) PG8_BAR; }
        if constexpr (!Epi::AFTER_DRAIN) { E(acc, cur, wr, wc, fr, fq); S.done(cur); }
        if (!has_next) break;
#pragma unroll
        for (int a = 0; a < 2; ++a)
#pragma unroll
            for (int b = 0; b < 2; ++b)
#pragma unroll
                for (int m = 0; m < 4; ++m)
#pragma unroll
                    for (int n = 0; n < 2; ++n) acc[a][b][m][n] = (f32x4){0.f, 0.f, 0.f, 0.f};
        cur = nxt; cA = nA; cB = nB; ++ui;
        if constexpr (ALIGN_EPI) { if (wr == 1) PG8_BAR; }
    }
    PG8_WAIT_V(0);
    if constexpr (!ALIGN_EPI) { if (wr == 0) PG8_BAR; }
    PG8_BAR;
    if constexpr (Epi::AFTER_DRAIN) { E.fused(acc, cur, wr, wc, fr, fq, lds, wid, lane); S.done(cur); }
#undef PG8_SA
#undef PG8_SB
#undef PG8_STAGE
#undef PG8_LDA
#undef PG8_LDB
#undef PG8_MMA
#undef PG8_WAIT_V
#undef PG8_WAIT_L
#undef PG8_BAR
#undef PG8_SCHED
}
}
namespace att {
typedef unsigned short bf16;
using bf16x8 = __attribute__((ext_vector_type(8))) short;
using s16x4  = __attribute__((ext_vector_type(4))) short;
using f32x16 = __attribute__((ext_vector_type(16))) float;
using u32x4  = __attribute__((ext_vector_type(4))) unsigned;
constexpr int   D = 128, NW = 8, QBLK = 32, KVBLK = 64;
constexpr float SCALE = 0.088388347648318440f;
constexpr float THR = 8.f;
#ifndef ATT_SDEPTH
#define ATT_SDEPTH 1
#endif
constexpr int SDEPTH = ATT_SDEPTH;
constexpr size_t SHM_V = KVBLK * D * 2, SHM_K = KVBLK * D * 2, SHM_ATTN = 2 * SHM_V + 2 * SHM_K + NW * 64 * 4;
#define KSWZ(row, colB) ((row) * 256 + ((colB) ^ (((row) & 7) << 4)))
#define SBAR() __builtin_amdgcn_sched_barrier(0)
__device__ __forceinline__ int crow(int r, int hi) { return (r & 3) + 8 * (r >> 2) + 4 * hi; }
__device__ __forceinline__ unsigned cvtpk(float lo, float hi) { unsigned r; asm volatile("v_cvt_pk_bf16_f32 %0, %1, %2" : "=v"(r) : "v"(lo), "v"(hi)); return r; }
__device__ __forceinline__ bf16x8 ld8(const bf16* p) { return *reinterpret_cast<const bf16x8*>(p); }

__device__ __forceinline__ void partialSM(f32x16& p0, f32x16& p1, float& m_reg, float& mn, float& alpha) {
  constexpr float C = SCALE * 1.4426950408889634f;
  float pmax = p0[0];
#pragma unroll
  for (int r = 1; r < 16; ++r) pmax = fmaxf(pmax, p0[r]);
#pragma unroll
  for (int r = 0; r < 16; ++r) pmax = fmaxf(pmax, p1[r]);
  { auto rr = __builtin_amdgcn_permlane32_swap(__float_as_uint(pmax), __float_as_uint(pmax), false, false);
    pmax = fmaxf(__uint_as_float(rr[0]), __uint_as_float(rr[1])); }
  if (__builtin_expect(__all(pmax - m_reg <= THR / SCALE), 1)) { mn = m_reg; alpha = 1.f; }
  else { mn = fmaxf(m_reg, pmax); alpha = __builtin_amdgcn_exp2f((m_reg - mn) * C); m_reg = mn; }
  float mnC = -mn * C;
#pragma unroll
  for (int r = 0; r < 16; ++r) p0[r] = fmaf(p0[r], C, mnC);
#pragma unroll
  for (int r = 0; r < 16; ++r) p1[r] = fmaf(p1[r], C, mnC);
#pragma unroll
  for (int r = 0; r < 16; ++r) p0[r] = __builtin_amdgcn_exp2f(p0[r]);
}
__device__ __forceinline__ void finishSM(f32x16& p0, f32x16& p1, float alpha, float& l_reg, bf16x8& pa0, bf16x8& pa1, bf16x8& pa2, bf16x8& pa3) {
#pragma unroll
  for (int r = 0; r < 16; ++r) p1[r] = __builtin_amdgcn_exp2f(p1[r]);
  float ps = 0;
#pragma unroll
  for (int r = 0; r < 16; ++r) ps += p0[r];
#pragma unroll
  for (int r = 0; r < 16; ++r) ps += p1[r];
  { auto rr = __builtin_amdgcn_permlane32_swap(__float_as_uint(ps), __float_as_uint(ps), false, false);
    ps = __uint_as_float(rr[0]) + __uint_as_float(rr[1]); }
  l_reg = l_reg * alpha + ps;
#define PK4(P, BASE, OUT) do { unsigned a0 = cvtpk(P[BASE + 0], P[BASE + 1]), a1 = cvtpk(P[BASE + 2], P[BASE + 3]);   \
    unsigned b0 = cvtpk(P[BASE + 4], P[BASE + 5]), b1 = cvtpk(P[BASE + 6], P[BASE + 7]);                              \
    auto r0 = __builtin_amdgcn_permlane32_swap(a0, b0, false, false); auto r1 = __builtin_amdgcn_permlane32_swap(a1, b1, false, false); \
    u32x4 w = {r0[0], r1[0], r0[1], r1[1]}; OUT = *reinterpret_cast<bf16x8*>(&w); } while (0)
  PK4(p0, 0, pa0); PK4(p0, 8, pa1); PK4(p1, 0, pa2); PK4(p1, 8, pa3);
#undef PK4
}
__device__ __forceinline__ void qkt(f32x16& p0, f32x16& p1, const bf16* Ks, const bf16x8* qr, int r32, int hi) {
  p0 = f32x16{}; p1 = f32x16{};
#pragma unroll
  for (int d0 = 0; d0 < 8; ++d0) { int cb = (d0 * 16 + hi * 8) * 2;
    bf16x8 b0 = *reinterpret_cast<const bf16x8*>((const char*)Ks + KSWZ(r32, cb));
    bf16x8 b1 = *reinterpret_cast<const bf16x8*>((const char*)Ks + KSWZ(32 + r32, cb));
    p0 = __builtin_amdgcn_mfma_f32_32x32x16_bf16(b0, qr[d0], p0, 0, 0, 0);
    p1 = __builtin_amdgcn_mfma_f32_32x32x16_bf16(b1, qr[d0], p1, 0, 0, 0); }
}
__device__ __forceinline__ void band_mask(f32x16& p0, f32x16& p1, int base, int hi) {
#pragma unroll
  for (int r = 0; r < 16; ++r) { const int kv = crow(r, hi); if ((unsigned)(base - kv) > 256u) p0[r] = -1e30f; if ((unsigned)(base - kv - 32) > 256u) p1[r] = -1e30f; }
}
__device__ __forceinline__ int v_st(int k, int c) { const int kk = (k & ~0xC) | ((k & 4) << 1) | ((k & 8) >> 1); return ((kk >> 3) * 4 + (c >> 5)) * 512 + ((kk & 7) * 32 + (c & 31)) * 2; }
__device__ __forceinline__ int v_rd_base(int lane) { return ((lane & 3) << 3) | (((lane >> 2) & 3) << 6) | (((lane >> 4) & 1) << 5) | (((lane >> 5) & 1) << 8); }
constexpr int v_rd_off(int d0, int ks, int half) { return d0 * 512 + ks * 4096 + half * 2048; }
template <int OFF> __device__ __forceinline__ s16x4 tr_read(int vb) {
  s16x4 r; asm volatile("ds_read_b64_tr_b16 %0, %1 offset:%2" : "=&v"(r) : "v"(vb), "i"(OFF) : "memory"); return r;
}
template <int D0> __device__ __forceinline__ void pv_one(f32x16& od, int vb, bf16x8 pa0, bf16x8 pa1, bf16x8 pa2, bf16x8 pa3) {
  const s16x4 l0 = tr_read<v_rd_off(D0, 0, 0)>(vb), h0 = tr_read<v_rd_off(D0, 0, 1)>(vb), l1 = tr_read<v_rd_off(D0, 1, 0)>(vb), h1 = tr_read<v_rd_off(D0, 1, 1)>(vb);
  const s16x4 l2 = tr_read<v_rd_off(D0, 2, 0)>(vb), h2 = tr_read<v_rd_off(D0, 2, 1)>(vb), l3 = tr_read<v_rd_off(D0, 3, 0)>(vb), h3 = tr_read<v_rd_off(D0, 3, 1)>(vb);
  asm volatile("s_waitcnt lgkmcnt(0)" ::: "memory"); SBAR();
#define PK(L, H) (bf16x8){L[0], L[1], L[2], L[3], H[0], H[1], H[2], H[3]}
  od = __builtin_amdgcn_mfma_f32_32x32x16_bf16(pa0, PK(l0, h0), od, 0, 0, 0);
  od = __builtin_amdgcn_mfma_f32_32x32x16_bf16(pa1, PK(l1, h1), od, 0, 0, 0);
  od = __builtin_amdgcn_mfma_f32_32x32x16_bf16(pa2, PK(l2, h2), od, 0, 0, 0);
  od = __builtin_amdgcn_mfma_f32_32x32x16_bf16(pa3, PK(l3, h3), od, 0, 0, 0);
#undef PK
}
__device__ __forceinline__ void pv_d0(f32x16* o, int vb, bf16x8 pa0, bf16x8 pa1, bf16x8 pa2, bf16x8 pa3) {
  pv_one<0>(o[0], vb, pa0, pa1, pa2, pa3); pv_one<1>(o[1], vb, pa0, pa1, pa2, pa3); pv_one<2>(o[2], vb, pa0, pa1, pa2, pa3); pv_one<3>(o[3], vb, pa0, pa1, pa2, pa3);
}
struct Src { const bf16* k0; const bf16* v0; int ld0; int n0; const bf16* k1; const bf16* v1; int ld1; int nt; int jb_lo; };

template <bool MASKED>
__device__ __forceinline__ void attn_unit(const bf16* __restrict__ Qb, int ldq, const Src S, float sinkv, bf16* __restrict__ Ob, int ldo, char* lds) {
  int tid_ = threadIdx.x; asm volatile("" : "+v"(tid_));
  const int tid = tid_, wid = tid >> 6, lane = tid & 63, r32 = lane & 31, hi = lane >> 5;
  bf16* V_lds = (bf16*)lds; bf16* K_lds = (bf16*)(lds + 2 * SHM_V);
  float* ws = (float*)(lds + 2 * SHM_V + 2 * SHM_K) + wid * 64; float* li_l = ws; float* al_l = ws + 32;
  float m_reg = -1e30f, l_reg = 0; f32x16 o[4] = {}; bf16x8 qr[8];
  const bf16* Qw = Qb + (long)(wid * QBLK + r32) * ldq + hi * 8;
#pragma unroll
  for (int d0 = 0; d0 < 8; ++d0) qr[d0] = ld8(Qw + d0 * 16);
  const int sr = tid >> 4, sc = (tid & 15) * 8, vst0 = v_st(sr, sc), vst1 = v_st(32 + sr, sc);
  const int vb0 = (int)(uintptr_t)V_lds + v_rd_base(lane);
  const int mbase = wid * QBLK + r32 + 256;
  const unsigned voff0 = (unsigned)(sr * S.ld0 + sc), voff1 = (unsigned)(sr * S.ld1 + sc);
  struct { bf16x8 vs0, vs1, ks0, ks1; } sr_[SDEPTH];
#define SLOAD(i, j) do { const int j_ = (j); const bool s0_ = j_ < S.n0; const int ld_ = s0_ ? S.ld0 : S.ld1; const long ro_ = (long)(s0_ ? j_ : j_ - S.n0) * KVBLK * ld_; \
    const bf16* kp_ = (s0_ ? S.k0 : S.k1) + ro_; const bf16* vp_ = (s0_ ? S.v0 : S.v1) + ro_; const bf16* kq_ = kp_ + 32l * ld_; const bf16* vq_ = vp_ + 32l * ld_; const unsigned vo_ = s0_ ? voff0 : voff1; \
    sr_[i].vs0 = ld8(vp_ + vo_); sr_[i].vs1 = ld8(vq_ + vo_); sr_[i].ks0 = ld8(kp_ + vo_); sr_[i].ks1 = ld8(kq_ + vo_); } while (0)
#define SWRITE(b, i) do { *(bf16x8*)((char*)V_lds + (b) * SHM_V + vst0) = sr_[i].vs0;          \
    *(bf16x8*)((char*)V_lds + (b) * SHM_V + vst1) = sr_[i].vs1; int kc = sc * 2;               \
    *(bf16x8*)((char*)K_lds + (b) * SHM_K + KSWZ(sr, kc)) = sr_[i].ks0;                       \
    *(bf16x8*)((char*)K_lds + (b) * SHM_K + KSWZ(32 + sr, kc)) = sr_[i].ks1; } while (0)
#define SWAIT() do { if constexpr (SDEPTH == 2) asm volatile("s_waitcnt vmcnt(4)" ::: "memory"); else asm volatile("s_waitcnt vmcnt(0)" ::: "memory"); } while (0)
#define RESC(a) do { if (__any((a) < 1.f)) { if (hi == 0) al_l[r32] = (a); asm volatile("s_waitcnt lgkmcnt(0)" ::: "memory"); \
    _Pragma("unroll") for (int d = 0; d < 4; ++d) _Pragma("unroll") for (int r = 0; r < 16; ++r) o[d][r] *= al_l[crow(r, hi)]; } } while (0)
#define MASK(P0, P1, j) do { if (MASKED) { const int j_ = (j); if (j_ >= S.n0) band_mask(P0, P1, mbase - 64 * (S.jb_lo + j_ - S.n0), hi); } } while (0)
  f32x16 pA0, pA1, pB0, pB1; float mnA, mnB, alA, alB; bf16x8 pa0, pa1, pa2, pa3; const int NT = S.nt;
  constexpr int SE = 0, SO = SDEPTH - 1;
  SLOAD(SE, 0); asm volatile("s_waitcnt vmcnt(0)" ::: "memory"); SWRITE(0, SE); __syncthreads();
  qkt(pA0, pA1, K_lds, qr, r32, hi); MASK(pA0, pA1, 0); partialSM(pA0, pA1, m_reg, mnA, alA);
  SLOAD(SO, 1); if constexpr (SDEPTH == 2) { if (2 < NT) SLOAD(SE, 2); }
  SWAIT(); SWRITE(1, SO); __syncthreads();
  for (int j = 1; j + 1 < NT; j += 2) {
    SBAR(); qkt(pB0, pB1, (bf16*)((char*)K_lds + SHM_K), qr, r32, hi); MASK(pB0, pB1, j);
    finishSM(pA0, pA1, alA, l_reg, pa0, pa1, pa2, pa3); SBAR();
    SLOAD(SO, j + SDEPTH); SBAR();
    pv_d0(o, vb0, pa0, pa1, pa2, pa3); partialSM(pB0, pB1, m_reg, mnB, alB);
    __syncthreads(); SWAIT(); SWRITE(0, SE);
    RESC(alB); __syncthreads();
    SBAR(); qkt(pA0, pA1, K_lds, qr, r32, hi); MASK(pA0, pA1, j + 1);
    finishSM(pB0, pB1, alB, l_reg, pa0, pa1, pa2, pa3); SBAR();
    if (SDEPTH == 1 || j + 3 < NT) SLOAD(SE, j + 1 + SDEPTH); SBAR();
    pv_d0(o, vb0 + (int)SHM_V, pa0, pa1, pa2, pa3); partialSM(pA0, pA1, m_reg, mnA, alA);
    __syncthreads(); SWAIT(); SWRITE(1, SO);
    RESC(alA); __syncthreads();
  }
  SBAR(); qkt(pB0, pB1, (bf16*)((char*)K_lds + SHM_K), qr, r32, hi); MASK(pB0, pB1, NT - 1);
  finishSM(pA0, pA1, alA, l_reg, pa0, pa1, pa2, pa3); SBAR();
  pv_d0(o, vb0, pa0, pa1, pa2, pa3); partialSM(pB0, pB1, m_reg, mnB, alB);
  __syncthreads(); RESC(alB);
  finishSM(pB0, pB1, alB, l_reg, pa0, pa1, pa2, pa3); SBAR();
  pv_d0(o, vb0 + (int)SHM_V, pa0, pa1, pa2, pa3);
  l_reg += __builtin_amdgcn_exp2f(sinkv * 1.4426950408889634f - m_reg * (SCALE * 1.4426950408889634f));
  if (hi == 0) li_l[r32] = l_reg; asm volatile("s_waitcnt lgkmcnt(0)" ::: "memory");
  float rli[16];
#pragma unroll
  for (int r = 0; r < 16; ++r) rli[r] = __builtin_amdgcn_rcpf(li_l[crow(r, hi)]);
  bf16* Ow = Ob + (long)(wid * QBLK) * ldo;
#pragma unroll
  for (int r = 0; r < 16; ++r) { const int orow = crow(r, hi);
#pragma unroll
    for (int d0 = 0; d0 < 4; ++d0) { const float v = o[d0][r] * rli[r]; const unsigned ub = __float_as_uint(v); Ow[(long)orow * ldo + d0 * 32 + r32] = (bf16)((ub + 0x7fffu + ((ub >> 16) & 1u)) >> 16); } }
  __syncthreads();
#undef SLOAD
#undef SWRITE
#undef SWAIT
#undef RESC
#undef MASK
}
#undef KSWZ
#undef SBAR
}
constexpr int NWAVES = 8;
constexpr int DM = 2048, NCTX = 8192, NLAT = 4096, MTOK = NCTX + NLAT, DEPTH = 4, DIN = 3072, DFF = 5632, DLRU = 512;
constexpr size_t O_YP = 0, O_YS = (size_t)NCTX * DM, O_CK = O_YS + (size_t)NLAT * DM, O_CV = O_CK + (size_t)32 * 4 * 256 * 256, O_ST = O_CV + (size_t)32 * 4 * 256 * 256, O_END = O_ST + (size_t)32 * 4 * 2 * 512;
#ifndef MK_PER_PHASE
#define MK_PER_PHASE 1
#endif
constexpr size_t MiB = 1u << 20;
constexpr size_t al(size_t x) { return (x + MiB - 1) / MiB * MiB; }
constexpr size_t WS_CTL = 0, CTL_ZERO_BYTES = 1 * MiB;
constexpr size_t SZ_WIN = (size_t)DIN * DM * 2, SZ_WOUT = (size_t)DM * DM * 2, SZ_W1 = (size_t)2 * DFF * DM * 2, SZ_W2 = (size_t)DM * DFF * 2;
constexpr size_t WS_WIN = 1 * MiB, WS_WOUT = WS_WIN + al(DEPTH * SZ_WIN), WS_W1 = WS_WOUT + al(DEPTH * SZ_WOUT), WS_W2 = WS_W1 + al(DEPTH * SZ_W1);
constexpr size_t WS_GW = WS_W2 + al(DEPTH * SZ_W2);
constexpr size_t WS_PW = WS_GW + al((size_t)DEPTH * 2 * 2 * 512 * 128 * 2);
constexpr size_t WS_CKB = WS_PW + al((size_t)DEPTH * 4 * 128 * 128 * 2);
constexpr size_t WS_CVB = WS_CKB + al((size_t)2 * 4 * 512 * 256 * 2);
constexpr size_t WS_MODP = WS_CVB + al((size_t)2 * 4 * 512 * 256 * 2);
constexpr size_t WS_MODV = WS_MODP + al((size_t)16 * 4 * 3 * 12288 * 4);
constexpr size_t WS_ROPE = WS_MODV + al((size_t)4 * 3 * 12288 * 4);
constexpr size_t WS_SUMM = WS_ROPE + 1 * MiB;
constexpr size_t WS_X = WS_SUMM + al((size_t)192 * 2 * 512 * 8);
constexpr size_t WS_H = WS_X + al((size_t)MTOK * DM * 4);
constexpr size_t WS_P = WS_H + al((size_t)MTOK * DM * 2);
constexpr size_t WS_MIX = WS_P + al((size_t)MTOK * DIN * 2);
constexpr size_t WS_ACT = WS_MIX + al((size_t)MTOK * DM * 2);
constexpr size_t WS_END = WS_ACT + al((size_t)MTOK * DFF * 2);
constexpr int CW_TMO = 0, CW_BAR = 4096;
constexpr int RING_OFF = 0, RING_BYTES = 131072;
constexpr int LDSCTL_OFF = RING_BYTES, MISC_OFF = LDSCTL_OFF + 320;
constexpr int LDS_BYTES = 147456;

#define GAS __attribute__((address_space(1)))
#define LAS __attribute__((address_space(3)))
typedef unsigned short bf16;
typedef unsigned v4u __attribute__((ext_vector_type(4)));
typedef float f32x4 __attribute__((ext_vector_type(4)));
typedef short bf16x8 __attribute__((ext_vector_type(8)));
#define LDS_WAIT() asm volatile("s_waitcnt lgkmcnt(0)" ::: "memory")
__device__ __forceinline__ unsigned f2bf(float f) { unsigned u = __builtin_bit_cast(unsigned, f); return (u + 0x7fffu + ((u >> 16) & 1u)) >> 16; }
__device__ __forceinline__ unsigned pk2(float lo, float hi) { return f2bf(lo) | (f2bf(hi) << 16); }
__device__ __forceinline__ float bf2f(unsigned short h) { return __uint_as_float((unsigned)h << 16); }
__device__ __forceinline__ float sigmoidf_(float x) { return __builtin_amdgcn_rcpf(1.0f + __builtin_amdgcn_exp2f(-1.4426950408889634f * x)); }
__device__ __forceinline__ float wave_sum(float v) {
#pragma unroll
    for (int o = 1; o < 64; o <<= 1) v += __shfl_xor(v, o);
    return v;
}
#define XB_TMO      128
#define XB_XCNT(j)  (256  + 64 * (j))
#define XB_XSUB(j)  (1280 + 64 * (j))
#define XB_XGEN(j)  (2304 + 64 * (j))
#define XB_TOP      3328
#define XB_TOPGEN   3392
#define XCD_BAR_WORDS 3456
#define XB_SPIN_CAP (1u << 18)

__device__ __forceinline__ unsigned xb_ld(unsigned* p)              { return __hip_atomic_load(p, __ATOMIC_RELAXED, __HIP_MEMORY_SCOPE_AGENT); }
__device__ __forceinline__ unsigned xb_add(unsigned* p, unsigned v) { return __hip_atomic_fetch_add(p, v, __ATOMIC_RELAXED, __HIP_MEMORY_SCOPE_AGENT); }
__device__ __forceinline__ unsigned xb_xcc_id() { return (unsigned)__builtin_amdgcn_s_getreg((3 << 11) | 20) & 0xFu; }
#define XB_SPIN(cond, bar) do { unsigned _sp = 0; while (cond) { __builtin_amdgcn_s_sleep(1); \
    if ((++_sp & 255u) == 0u) { if (xb_ld(&(bar)[XB_TMO])) break; if (_sp > XB_SPIN_CAP) { atomicAdd(&(bar)[XB_TMO], 1u); break; } } } } while (0)

struct XcdBarrier {
    unsigned* bar; unsigned x;
    volatile LAS unsigned* st;
};

__device__ __forceinline__ XcdBarrier xcd_barrier_post(unsigned* bar, volatile LAS unsigned* st) {
    XcdBarrier b; b.bar = bar; b.x = xb_xcc_id(); b.st = st;
    if (threadIdx.x == 0) (void)xb_add(&bar[XB_XCNT(b.x)], 1u);
    return b;
}
__device__ __forceinline__ void xcd_barrier_complete(unsigned* bar, unsigned x, unsigned& nloc, unsigned& nx) {
    const unsigned G = gridDim.x * gridDim.y * gridDim.z;
    unsigned sum, cnt, mine, sp = 0u;
    for (;;) {
        sum = 0u; cnt = 0u; mine = 0u;
#pragma unroll
        for (unsigned j = 0; j < 16; ++j) { const unsigned c = xb_ld(&bar[XB_XCNT(j)]); sum += c; cnt += (c > 0u) ? 1u : 0u; mine = (j == x) ? c : mine; }
        if (sum == G) break;
        __builtin_amdgcn_s_sleep(1);
        if ((++sp & 255u) == 0u) { if (xb_ld(&bar[XB_TMO])) break; if (sp > XB_SPIN_CAP) { atomicAdd(&bar[XB_TMO], 1u); break; } }
    }
    nloc = mine > 0u ? mine : 1u; nx = cnt > 0u ? cnt : 1u;
}

__device__ __forceinline__ void xcd_barrier(const XcdBarrier& b) {
    asm volatile("s_waitcnt vmcnt(0)" ::: "memory");
    __syncthreads();
    if (threadIdx.x == 0) {
        unsigned* bar = b.bar;
        __builtin_amdgcn_s_waitcnt(0);
        unsigned nloc = b.st[0], nx = b.st[1];
        if (nloc == 0u) { xcd_barrier_complete(bar, b.x, nloc, nx); b.st[0] = nloc; b.st[1] = nx; }
        const unsigned old = xb_add(&bar[XB_XSUB(b.x)], 1u);
        const unsigned gen = old / nloc;
        if (old + 1u == (gen + 1u) * nloc) {
            __builtin_amdgcn_fence(__ATOMIC_RELEASE, "agent");
            asm volatile("s_waitcnt vmcnt(0)" ::: "memory");
            const unsigned og = xb_add(&bar[XB_TOP], 1u);
            const unsigned tg = og / nx;
            if (og + 1u == (tg + 1u) * nx) xb_add(&bar[XB_TOPGEN], 1u);
            else XB_SPIN(xb_ld(&bar[XB_TOPGEN]) == tg, bar);
            __builtin_amdgcn_fence(__ATOMIC_ACQUIRE, "agent");
            xb_add(&bar[XB_XGEN(b.x)], 1u);
            asm volatile("s_waitcnt vmcnt(0)" ::: "memory");
        } else {
            XB_SPIN(xb_ld(&bar[XB_XGEN(b.x)]) == gen, bar);
            __builtin_amdgcn_fence(__ATOMIC_ACQUIRE, "agent");
            asm volatile("s_waitcnt vmcnt(0)" ::: "memory");
        }
    }
    __syncthreads();
}
struct Args { const float* in[26]; float* out; unsigned char* ws; int ph_lo, ph_hi; };

__device__ __forceinline__ int src_col(int kind, int n) {
    if (kind == 1) { if (n < 1280) { const int p = n & 127, j = p >> 1, s = p & 1; return (n & ~127) + (j >> 5) * 64 + s * 32 + (j & 31); } return n; }
    if (kind == 2) { const int pn = n >> 8, bj = (n >> 7) & 1, j = n & 127; return bj * DFF + pn * 128 + j; }
    return n;
}
__device__ __forceinline__ void p0_transpose_item(const float* W, int K, int N, bf16* WT, LAS float* scr, int item, int lane, int kind) {
    const int nblk = N / 32, kb = item / nblk, nb = item % nblk, k0 = 64 * kb, n0 = 32 * nb;
    const int sc = src_col(kind, n0 + (lane & 31));
#pragma unroll 8
    for (int i = 0; i < 32; ++i) { const int kk = 2 * i + (lane >> 5); scr[kk * 33 + (lane & 31)] = W[(size_t)(k0 + kk) * N + sc]; }
    LDS_WAIT(); asm volatile("" ::: "memory");
    const int c = lane & 7;
#pragma unroll
    for (int j = 0; j < 4; ++j) { const int n = (lane >> 3) + 8 * j; const LAS float* s = scr + (8 * c) * 33 + n;
        v4u o; o.x = pk2(s[0 * 33], s[1 * 33]); o.y = pk2(s[2 * 33], s[3 * 33]); o.z = pk2(s[4 * 33], s[5 * 33]); o.w = pk2(s[6 * 33], s[7 * 33]);
        *(GAS v4u*)(WT + (size_t)(n0 + n) * K + k0 + 8 * c) = o; }
    LDS_WAIT(); asm volatile("" ::: "memory");
}
constexpr int IT_WIN = (DM / 64) * (DIN / 32), IT_WOUT = (DM / 64) * (DM / 32), IT_W1 = (DM / 64) * (2 * DFF / 32), IT_W2 = (DFF / 64) * (DM / 32), IT_LAYER = IT_WIN + IT_WOUT + IT_W1 + IT_W2;

__device__ __forceinline__ void p0_prologue(const Args& a, LAS unsigned char* lds, int tid, int lane, int wave, int G) {
    unsigned char* ws = a.ws;
    LAS float* sil = (LAS float*)(lds + 69632);
    for (int e = tid; e < 3 * 2048; e += 512) { const int cd = e >> 11, k = e & 2047; const float v = cd == 0 ? a.in[6][k] : a.in[5][(cd - 1) * 2048 + k]; sil[e] = v * sigmoidf_(v); }
    __syncthreads();
    float* modp = (float*)(ws + WS_MODP);
    for (int it = blockIdx.x; it < 384; it += G) {
        const int l = it / 96, rem = it % 96, ks = rem / 6, cb = rem % 6, col = cb * 2048 + tid * 4;
        const float* Wp = a.in[7] + ((size_t)l * 2048 + ks * 128) * 12288 + col;
        f32x4 a0 = (f32x4){0.f, 0.f, 0.f, 0.f}, a1 = a0, a2 = a0;
#pragma unroll 8
        for (int k = 0; k < 128; ++k) { const f32x4 w = *(const f32x4*)(Wp + (size_t)k * 12288); a0 += sil[ks * 128 + k] * w; a1 += sil[2048 + ks * 128 + k] * w; a2 += sil[4096 + ks * 128 + k] * w; }
        float* o = modp + ((size_t)(ks * 4 + l) * 3) * 12288 + col;
        *(f32x4*)o = a0; *(f32x4*)(o + 12288) = a1; *(f32x4*)(o + 2 * 12288) = a2;
    }
    LAS float* scr = (LAS float*)(lds + wave * 8448);
    const int gw = blockIdx.x * NWAVES + wave, NGW = G * NWAVES;
    for (int it = gw; it < DEPTH * IT_LAYER; it += NGW) {
        const int l = it / IT_LAYER; int r = it % IT_LAYER;
        if (r < IT_WIN) { p0_transpose_item(a.in[11] + (size_t)l * DM * DIN, DM, DIN, (bf16*)(ws + WS_WIN + l * SZ_WIN), scr, r, lane, 1); continue; } r -= IT_WIN;
        if (r < IT_WOUT) { p0_transpose_item(a.in[22] + (size_t)l * DM * DM, DM, DM, (bf16*)(ws + WS_WOUT + l * SZ_WOUT), scr, r, lane, 0); continue; } r -= IT_WOUT;
        if (r < IT_W1) { p0_transpose_item(a.in[23] + (size_t)l * DM * 2 * DFF, DM, 2 * DFF, (bf16*)(ws + WS_W1 + l * SZ_W1), scr, r, lane, 2); continue; } r -= IT_W1;
        p0_transpose_item(a.in[24] + (size_t)l * DFF * DM, DFF, DM, (bf16*)(ws + WS_W2 + l * SZ_W2), scr, r, lane, 0);
    }
    const int gt = blockIdx.x * 512 + tid, NGT = G * 512;
    bf16* GW = (bf16*)(ws + WS_GW);
    for (int e = gt; e < DEPTH * 2 * 2 * 512 * 128; e += NGT) { const int k = e & 127, o = (e >> 7) & 511, g = (e >> 16) & 1, d = (e >> 17) & 1, l = e >> 18, n = o >> 7, dd = o & 127;
        GW[e] = (bf16)f2bf((g ? a.in[17] : a.in[15])[((size_t)((l * 2 + d) * 4 + n) * 128 + k) * 128 + dd]); }
    bf16* PW = (bf16*)(ws + WS_PW);
    for (int e = gt; e < DEPTH * 4 * 128 * 128; e += NGT) { const int k = e & 127, dd = (e >> 7) & 127, g = (e >> 14) & 3, l = e >> 16; PW[e] = (bf16)f2bf(a.in[20][((size_t)(l * 4 + g) * 128 + k) * 128 + dd]); }
    bf16* CKB = (bf16*)(ws + WS_CKB); bf16* CVB = (bf16*)(ws + WS_CVB);
    for (int e = gt; e < 2 * 4 * 512 * 256; e += NGT) { const int col = e & 255, rest = e >> 8, kvh = col >> 7, p = col & 127, j = p >> 1, s = p & 1, nat = (j >> 5) * 64 + s * 32 + (j & 31);
        CKB[e] = (bf16)f2bf(a.in[2][(size_t)rest * 256 + kvh * 128 + nat]); CVB[e] = (bf16)f2bf(a.in[3][e]); }
    float* rope = (float*)(ws + WS_ROPE);
    for (int e = gt; e < 2048; e += NGT) { const int p = e >> 5, i = e & 31; const float inv = __builtin_amdgcn_exp2f(-(float)i * 0.41524101186092029f); const float ang = (float)p * inv;
        double rev = (double)ang * 0.15915494309189535; rev -= (double)(long long)rev; const float rf = (float)rev;
        rope[e] = __builtin_amdgcn_cosf(rf); rope[2048 + e] = __builtin_amdgcn_sinf(rf); }
}
__device__ __forceinline__ void p1_modreduce(const Args& a, int tid, int G) {
    const float* modp = (const float*)(a.ws + WS_MODP); float* modv = (float*)(a.ws + WS_MODV);
    for (int e4 = blockIdx.x * 512 + tid; e4 < 4 * 3 * 12288 / 4; e4 += G * 512) { const int e = e4 * 4, n = e % 12288, lc = e / 12288, l = lc / 3, cd = lc % 3;
        f32x4 v = *(const f32x4*)(a.in[8] + l * 12288 + n);
#pragma unroll
        for (int ks = 0; ks < 16; ++ks) v += *(const f32x4*)(modp + ((size_t)(ks * 4 + l) * 3 + cd) * 12288 + n);
        *(f32x4*)(modv + e) = v; }
}
__device__ __forceinline__ void norm_phase(const float* xc, const float* xl, const float* gn, const float* modl, int sh_idx, int sc_idx, bf16* H, int gw, int NGW, int lane) {
    const int rpw = (MTOK + NGW - 1) / NGW; int ccur = -1; f32x4 ga[8], sh[8];
    for (int m = gw * rpw; m < (gw + 1) * rpw && m < MTOK; ++m) {
        const int cond = m < NCTX ? 0 : (m < NCTX + 2048 ? 1 : 2);
        if (cond != ccur) { ccur = cond; const float* sc = modl + cond * 12288 + sc_idx * 2048; const float* sf = modl + cond * 12288 + sh_idx * 2048;
#pragma unroll
            for (int j = 0; j < 8; ++j) { const f32x4 g = *(const f32x4*)(gn + 256 * j + 4 * lane), s = *(const f32x4*)(sc + 256 * j + 4 * lane); ga[j] = g * (1.0f + s); sh[j] = *(const f32x4*)(sf + 256 * j + 4 * lane); } }
        const float* xr = m < NCTX ? xc + (size_t)m * DM : xl + (size_t)(m - NCTX) * DM;
        f32x4 v[8]; float ss = 0.f;
#pragma unroll
        for (int j = 0; j < 8; ++j) { v[j] = *(const f32x4*)(xr + 256 * j + 4 * lane); ss += (v[j].x * v[j].x + v[j].y * v[j].y) + (v[j].z * v[j].z + v[j].w * v[j].w); }
        const float rstd = 1.0f / sqrtf(wave_sum(ss) * (1.0f / DM) + 1e-6f);
        unsigned long long* o8 = (unsigned long long*)(H + (size_t)m * DM) + lane;
#pragma unroll
        for (int j = 0; j < 8; ++j) { const f32x4 y = v[j] * rstd * ga[j] + sh[j]; o8[64 * j] = (unsigned long long)pk2(y.x, y.y) | ((unsigned long long)pk2(y.z, y.w) << 32); }
    }
}
__device__ __forceinline__ void final_norm_phase(const float* x, const float* gn, float* out, int gw, int NGW, int lane) {
    f32x4 ga[8];
#pragma unroll
    for (int j = 0; j < 8; ++j) ga[j] = *(const f32x4*)(gn + 256 * j + 4 * lane);
    for (int m = gw; m < MTOK; m += NGW) {
        const float* xr = x + (size_t)m * DM; f32x4 v[8]; float ss = 0.f;
#pragma unroll
        for (int j = 0; j < 8; ++j) { v[j] = *(const f32x4*)(xr + 256 * j + 4 * lane); ss += (v[j].x * v[j].x + v[j].y * v[j].y) + (v[j].z * v[j].z + v[j].w * v[j].w); }
        const float rstd = 1.0f / sqrtf(wave_sum(ss) * (1.0f / DM) + 1e-6f);
#pragma unroll
        for (int j = 0; j < 8; ++j) *(f32x4*)(out + (size_t)m * DM + 256 * j + 4 * lane) = v[j] * rstd * ga[j];
    }
}
struct SeqInfo { int T, seq, t0, seqrow0, nch, cc, chunk0; bool lat; };
__device__ __forceinline__ SeqInfo seq_info(int chunk) {
    SeqInfo s; const int r0 = chunk * 64;
    if (r0 < NCTX) { s.T = 256; s.seq = r0 >> 8; s.t0 = r0 & 255; s.seqrow0 = s.seq * 256; s.nch = 4; s.chunk0 = s.seq * 4; s.lat = false; }
    else { const int rr = r0 - NCTX; s.T = 2048; s.seq = rr >> 11; s.t0 = rr & 2047; s.seqrow0 = NCTX + s.seq * 2048; s.nch = 32; s.chunk0 = 128 + s.seq * 32; s.lat = true; }
    s.cc = s.t0 >> 6; return s;
}
constexpr int LU_UB = 0, LU_UF = 17408, LU_A = LU_UF + 33792, LU_B = LU_A + 33792, LU_END = LU_B + 33792;
static_assert(LU_END <= RING_BYTES, "LRU unit LDS");
template <int PASS>
__device__ __forceinline__ void lru_unit(const Args& a, LAS unsigned char* lds, int l, int chunk, int nblk, int tid, int lane, int wave) {
    const SeqInfo si = seq_info(chunk); const int r0 = chunk * 64;
    const bf16* P = (const bf16*)(a.ws + WS_P); const bf16* GW = (const bf16*)(a.ws + WS_GW);
    float2* summ = (float2*)(a.ws + WS_SUMM);
    LAS float* UF = (LAS float*)(lds + LU_UF); LAS float* A_ = (LAS float*)(lds + LU_A); LAS float* B_ = (LAS float*)(lds + LU_B);
    {
        const int cg = tid & 15, tg = tid >> 4, c8 = cg * 8, cb = nblk * 128 + c8;
        float xw[5][8];
#pragma unroll
        for (int j = 0; j < 5; ++j) { const int tl = si.t0 + tg * 2 + j - 2;
            if (tl >= 0 && tl < si.T) { const bf16x8 v = *(const bf16x8*)(P + (size_t)(si.seqrow0 + tl) * DIN + 1536 + cb);
#pragma unroll
                for (int e = 0; e < 8; ++e) xw[j][e] = bf2f((unsigned short)v[e]); }
            else {
#pragma unroll
                for (int e = 0; e < 8; ++e) xw[j][e] = 0.f; } }
        float cw[4][8], cbias[8];
#pragma unroll
        for (int j = 0; j < 4; ++j) { const f32x4 w0 = *(const f32x4*)(a.in[13] + (size_t)(l * 4 + j) * 512 + cb), w1 = *(const f32x4*)(a.in[13] + (size_t)(l * 4 + j) * 512 + cb + 4);
            cw[j][0] = w0.x; cw[j][1] = w0.y; cw[j][2] = w0.z; cw[j][3] = w0.w; cw[j][4] = w1.x; cw[j][5] = w1.y; cw[j][6] = w1.z; cw[j][7] = w1.w; }
        { const f32x4 b0 = *(const f32x4*)(a.in[14] + l * 512 + cb), b1 = *(const f32x4*)(a.in[14] + l * 512 + cb + 4);
            cbias[0] = b0.x; cbias[1] = b0.y; cbias[2] = b0.z; cbias[3] = b0.w; cbias[4] = b1.x; cbias[5] = b1.y; cbias[6] = b1.z; cbias[7] = b1.w; }
#pragma unroll
        for (int q = 0; q < 2; ++q) { const int t = tg * 2 + q; float u[8];
#pragma unroll
            for (int e = 0; e < 8; ++e) u[e] = cbias[e] + cw[0][e] * xw[q][e] + cw[1][e] * xw[q + 1][e] + cw[2][e] * xw[q + 2][e] + cw[3][e] * xw[q + 3][e];
            *(LAS f32x4*)(UF + t * 132 + c8) = (f32x4){u[0], u[1], u[2], u[3]}; *(LAS f32x4*)(UF + t * 132 + c8 + 4) = (f32x4){u[4], u[5], u[6], u[7]};
            v4u w; w.x = pk2(u[0], u[1]); w.y = pk2(u[2], u[3]); w.z = pk2(u[4], u[5]); w.w = pk2(u[6], u[7]);
            *(LAS v4u*)(lds + LU_UB + t * 272 + c8 * 2) = w; }
    }
    __syncthreads();
    const int q = lane >> 4, cl = lane & 15, ch = wave * 16 + cl, chg = nblk * 128 + ch;
    const int c2 = nblk * 128 + tid;
    float y[64];
#pragma unroll
    for (int d = 0; d < 2; ++d) {
        f32x4 acc[2][4];
#pragma unroll
        for (int g = 0; g < 2; ++g)
#pragma unroll
            for (int m = 0; m < 4; ++m) acc[g][m] = (f32x4){0.f, 0.f, 0.f, 0.f};
#pragma unroll
        for (int ks = 0; ks < 4; ++ks) {
            bf16x8 bw[2];
#pragma unroll
            for (int g = 0; g < 2; ++g) bw[g] = *(const bf16x8*)(GW + ((size_t)((l * 2 + d) * 2 + g) * 512 + chg) * 128 + ks * 32 + 8 * q);
#pragma unroll
            for (int m = 0; m < 4; ++m) { const bf16x8 au = *(const LAS bf16x8*)(lds + LU_UB + (m * 16 + cl) * 272 + (ks * 32 + 8 * q) * 2);
#pragma unroll
                for (int g = 0; g < 2; ++g) acc[g][m] = __builtin_amdgcn_mfma_f32_16x16x32_bf16(au, bw[g], acc[g][m], 0, 0, 0); }
        }
        {
            const float bav = a.in[16][(l * 2 + d) * 512 + chg], bxv = a.in[18][(l * 2 + d) * 512 + chg], lamv = a.in[19][(l * 2 + d) * 512 + chg];
            const float ls8 = -8.0f * log1pf(expf(-lamv));
#pragma unroll
            for (int m = 0; m < 4; ++m)
#pragma unroll
                for (int rg = 0; rg < 4; ++rg) { const int t = m * 16 + 4 * q + rg;
                    const float r = sigmoidf_(acc[0][m][rg] + bav), ig = sigmoidf_(acc[1][m][rg] + bxv);
                    const float la = ls8 * r, av = __builtin_amdgcn_exp2f(la * 1.4426950408889634f), x2 = 2.0f * la;
                    const float om = x2 > -0.02f ? -x2 * (1.0f + 0.5f * x2 * (1.0f + x2 * 0.33333333f)) : 1.0f - av * av;
                    const float bv = __builtin_amdgcn_sqrtf(om) * ig * UF[t * 132 + ch];
                    A_[t * 132 + ch] = av; B_[t * 132 + ch] = bv; }
        }
        __syncthreads();
        if (tid < 128) {
            if (PASS == 1) {
                float Ap = 1.f, Bp = 0.f;
#pragma unroll 8
                for (int i = 0; i < 64; ++i) { const int t = d ? 63 - i : i; const float av = A_[t * 132 + tid], bv = B_[t * 132 + tid]; Bp = av * Bp + bv; Ap *= av; }
                summ[(size_t)(chunk * 2 + d) * 512 + c2] = make_float2(Ap, Bp);
            } else {
                float h = si.lat ? a.in[4][(size_t)((si.seq * 4 + l) * 2 + d) * 512 + c2] : 0.f;
                if (d == 0) { for (int j = 0; j < si.cc; ++j) { const float2 s = summ[(size_t)((si.chunk0 + j) * 2 + 0) * 512 + c2]; h = s.x * h + s.y; } }
                else { for (int j = si.nch - 1; j > si.cc; --j) { const float2 s = summ[(size_t)((si.chunk0 + j) * 2 + 1) * 512 + c2]; h = s.x * h + s.y; } }
#pragma unroll
                for (int i = 0; i < 64; ++i) { const int t = d ? 63 - i : i; h = A_[t * 132 + tid] * h + B_[t * 132 + tid]; if (d == 0) y[t] = h; else y[t] += h; }
                if (!si.lat) { if (d == 0 && si.cc == si.nch - 1) a.out[O_ST + (size_t)((si.seq * 4 + l) * 2 + 0) * 512 + c2] = h;
                               if (d == 1 && si.cc == 0) a.out[O_ST + (size_t)((si.seq * 4 + l) * 2 + 1) * 512 + c2] = h; }
            }
        }
        __syncthreads();
    }
    if (PASS == 2 && tid < 128) {
        bf16* mix = (bf16*)(a.ws + WS_MIX);
#pragma unroll
        for (int t = 0; t < 64; ++t) { const float g = bf2f(P[(size_t)(r0 + t) * DIN + 2048 + c2]); const float z = 0.7978845608028654f * (g + 0.044715f * g * g * g);
            mix[(size_t)(r0 + t) * DM + 1024 + c2] = (bf16)f2bf(y[t] * g * sigmoidf_(2.0f * z)); }
    }
}
__device__ __forceinline__ void pool_unit(const Args& a, LAS unsigned char* lds, int l, int chunk, int g, int tid, int lane, int wave) {
    const SeqInfo si = seq_info(chunk); const int r0 = chunk * 64;
    const bf16* P = (const bf16*)(a.ws + WS_P); const bf16* PW = (const bf16*)(a.ws + WS_PW); bf16* mix = (bf16*)(a.ws + WS_MIX);
    {
        const int w2 = 1 << g, cg = tid & 15, tg = tid >> 4, c8 = cg * 8, colp = 2560 + g * 128 + c8;
#pragma unroll
        for (int qq = 0; qq < 2; ++qq) { const int t = tg * 2 + qq, tl = si.t0 + t; const int lo = tl - w2 > 0 ? tl - w2 : 0, hi = tl + w2 < si.T ? tl + w2 : si.T;
            float s[8];
#pragma unroll
            for (int e = 0; e < 8; ++e) s[e] = 0.f;
            for (int r = lo; r < hi; ++r) { const bf16x8 v = *(const bf16x8*)(P + (size_t)(si.seqrow0 + r) * DIN + colp);
#pragma unroll
                for (int e = 0; e < 8; ++e) s[e] += bf2f((unsigned short)v[e]); }
            const bf16x8 sv = *(const bf16x8*)(P + (size_t)(si.seqrow0 + tl) * DIN + colp); const float inv = 1.0f / (float)(hi - lo);
            float pz[8];
#pragma unroll
            for (int e = 0; e < 8; ++e) pz[e] = s[e] * inv - bf2f((unsigned short)sv[e]);
            v4u w; w.x = pk2(pz[0], pz[1]); w.y = pk2(pz[2], pz[3]); w.z = pk2(pz[4], pz[5]); w.w = pk2(pz[6], pz[7]);
            *(LAS v4u*)(lds + LU_UB + t * 272 + c8 * 2) = w; }
    }
    __syncthreads();
    const int q = lane >> 4, cl = lane & 15, dch = wave * 16 + cl;
    f32x4 acc[4];
#pragma unroll
    for (int m = 0; m < 4; ++m) acc[m] = (f32x4){0.f, 0.f, 0.f, 0.f};
#pragma unroll
    for (int ks = 0; ks < 4; ++ks) { const bf16x8 bw = *(const bf16x8*)(PW + ((size_t)(l * 4 + g) * 128 + dch) * 128 + ks * 32 + 8 * q);
#pragma unroll
        for (int m = 0; m < 4; ++m) { const bf16x8 au = *(const LAS bf16x8*)(lds + LU_UB + (m * 16 + cl) * 272 + (ks * 32 + 8 * q) * 2); acc[m] = __builtin_amdgcn_mfma_f32_16x16x32_bf16(au, bw, acc[m], 0, 0, 0); } }
    const float sc = a.in[21][l * 512 + g * 128 + dch];
#pragma unroll
    for (int m = 0; m < 4; ++m)
#pragma unroll
        for (int rg = 0; rg < 4; ++rg) { const int t = m * 16 + 4 * q + rg; mix[(size_t)(r0 + t) * DM + 1536 + g * 128 + dch] = (bf16)f2bf(acc[m][rg] * sc); }
    __syncthreads();
}
__device__ __forceinline__ void attn_ctx_unit(const Args& a, char* lds, int l, int i) {
    const int b = i >> 3, h = i & 7, kvh = h >> 2;
    const bf16* P = (const bf16*)(a.ws + WS_P); bf16* mix = (bf16*)(a.ws + WS_MIX);
    att::Src S; S.k0 = P + (size_t)(b * 256) * DIN + 1024 + kvh * 128; S.v0 = S.k0 + 256; S.ld0 = DIN; S.n0 = 4; S.k1 = S.k0; S.v1 = S.v0; S.ld1 = DIN; S.nt = 4; S.jb_lo = 0;
    att::attn_unit<false>(P + (size_t)(b * 256) * DIN + h * 128, DIN, S, a.in[12][l * 8 + h], mix + (size_t)(b * 256) * DM + h * 128, DM, lds);
}
__device__ __forceinline__ void attn_lat_unit(const Args& a, char* lds, int l, int i) {
    const int b = i >> 6, h = (i >> 3) & 7, qb = i & 7, kvh = h >> 2, q0 = qb * 256, rowbase = NCTX + b * 2048;
    const bf16* P = (const bf16*)(a.ws + WS_P); bf16* mix = (bf16*)(a.ws + WS_MIX);
    const bf16* CKB = (const bf16*)(a.ws + WS_CKB); const bf16* CVB = (const bf16*)(a.ws + WS_CVB);
    const int jb_lo = qb == 0 ? 2 : 0, jb_hi = qb == 7 ? 6 : 8;
    att::Src S; S.k0 = CKB + (size_t)((b * 4 + l) * 512) * 256 + kvh * 128; S.v0 = CVB + (size_t)((b * 4 + l) * 512) * 256 + kvh * 128; S.ld0 = 256; S.n0 = 8;
    S.k1 = P + (size_t)(rowbase + q0 - 128 + jb_lo * 64) * DIN + 1024 + kvh * 128; S.v1 = S.k1 + 256; S.ld1 = DIN; S.nt = 8 + jb_hi - jb_lo; S.jb_lo = jb_lo;
    att::attn_unit<true>(P + (size_t)(rowbase + q0) * DIN + h * 128, DIN, S, a.in[12][l * 8 + h], mix + (size_t)(rowbase + q0) * DM + h * 128, DM, lds);
}
constexpr int N_PHASES = 2 + 8 * DEPTH + 1;
__device__ __forceinline__ int att_index(int w, int s, int G) {
    if (G == 256) { if (w < 128) return s == 0 ? w : -1; return s < 2 ? 128 + 2 * (w - 128) + s : -1; }
    const int i = w + s * G; return i < 384 ? i : -1;
}
__device__ __forceinline__ int lru_index(int w, int s, int G) {
    if (G == 256) { if (w >= 128) return s < 5 ? (w - 128) * 5 + s : -1; return s == 0 ? 640 + w : -1; }
    const int i = w + s * G; return i < 768 ? i : -1;
}
#if defined(__HIP_DEVICE_COMPILE__)
#define PHASE_ARGS const __attribute__((address_space(4))) Args* ap_ = (const __attribute__((address_space(4))) Args*)__builtin_amdgcn_kernarg_segment_ptr(); asm volatile("" : "+s"(ap_)); const Args a = *ap_;
#else
#define PHASE_ARGS const Args a = a_;
#endif
#define PHASE_LOCALS int tid = threadIdx.x; asm volatile("" : "+v"(tid)); const int lane = tid & 63, wave = __builtin_amdgcn_readfirstlane(tid >> 6); PHASE_ARGS \
    unsigned char* ws = a.ws; const int G = gridDim.x; const int gw = blockIdx.x * NWAVES + wave, NGW = G * NWAVES; (void)lane; (void)gw; (void)NGW; (void)ws;
__global__ void __launch_bounds__(NWAVES * 64, 2) fwd_kernel(Args a_) {
    extern __shared__ __attribute__((aligned(16))) unsigned char lds_raw[];
    LAS unsigned char* lds = (LAS unsigned char*)lds_raw;
    for (int u = threadIdx.x; u < (LDS_BYTES - LDSCTL_OFF) / 4; u += NWAVES * 64) ((LAS unsigned*)(lds + LDSCTL_OFF))[u] = 0u;
    __syncthreads();
#if !MK_PER_PHASE
    XcdBarrier bar = xcd_barrier_post((unsigned*)(a_.ws + WS_CTL) + CW_BAR, (volatile LAS unsigned*)(lds + MISC_OFF) + 8);
#define SEAM(k) do { if ((k) + 1 < hi) xcd_barrier(bar); } while (0)
#else
#define SEAM(k) do { } while (0)
#endif
    const int lo = a_.ph_lo, hi = a_.ph_hi;
#define IN(k) (lo <= (k) && (k) < hi)
#define XBUF ((float*)(ws + WS_X))
#define HB ((bf16*)(ws + WS_H))
#define PB ((bf16*)(ws + WS_P))
#define MIXB ((bf16*)(ws + WS_MIX))
#define ACTB ((bf16*)(ws + WS_ACT))
#define MODL ((const float*)(ws + WS_MODV) + (size_t)l * 3 * 12288)
#define ROPE ((const float*)(ws + WS_ROPE))
#define XC (l == 0 ? a.in[0] : (const float*)XBUF)
#define XL (l == 0 ? a.in[1] : (const float*)XBUF + (size_t)NCTX * DM)

#ifndef NO_PRO
    if (IN(0)) { { PHASE_LOCALS p0_prologue(a, lds, tid, lane, wave, G); } SEAM(0); }
    if (IN(1)) { { PHASE_LOCALS p1_modreduce(a, tid, G); } SEAM(1); }
#endif
    for (int l = 0; l < DEPTH; ++l) {
        const int pb = 2 + 8 * l;
#ifndef NO_NORM
        if (IN(pb + 0)) { { PHASE_LOCALS norm_phase(XC, XL, a.in[9] + l * DM, MODL, 0, 1, HB, gw, NGW, lane); } SEAM(pb + 0); }
#endif
#ifndef NO_G1
        if (IN(pb + 1)) {
            { PHASE_LOCALS
            pg8::Gemm g{HB, (const bf16*)(ws + WS_WIN + l * SZ_WIN), MTOK, DIN, DM}; pg8::StaticOrder S; S.init(MTOK, DIN, G, (int)blockIdx.x);
            pg8::EpiIn E{PB, a.out + O_CK, a.out + O_CV, ROPE, ROPE + 2048, l};
            pg8::gemm_phase<pg8::EpiIn, pg8::StaticOrder, true, true>(lds + RING_OFF, g, S, E); }
            SEAM(pb + 1);
        }
#endif
#ifndef NO_LRU1
        if (IN(pb + 2)) { { PHASE_LOCALS for (int u = blockIdx.x; u < 768; u += G) lru_unit<1>(a, lds, l, u >> 2, u & 3, tid, lane, wave); } SEAM(pb + 2); }
#endif
        if (IN(pb + 3)) {
#ifndef NO_ATT
            { PHASE_LOCALS
            for (int s = 0;; ++s) { const int i = att_index((int)blockIdx.x, s, G); if (i < 0) break; if (i < 128) attn_lat_unit(a, (char*)lds_raw, l, i); else attn_ctx_unit(a, (char*)lds_raw, l, i - 128); } }
#endif
            __syncthreads();
#ifndef NO_LRU2
            { PHASE_LOCALS
            for (int s = 0;; ++s) { const int u = lru_index((int)blockIdx.x, s, G); if (u < 0) break; lru_unit<2>(a, lds, l, u >> 2, u & 3, tid, lane, wave); } }
#endif
#ifndef NO_POOL
            { PHASE_LOCALS for (int u = blockIdx.x; u < 768; u += G) pool_unit(a, lds, l, u >> 2, u & 3, tid, lane, wave); }
#endif
            SEAM(pb + 3);
        }
#ifndef NO_G2
        if (IN(pb + 4)) {
            { PHASE_LOCALS
            pg8::Gemm g{MIXB, (const bf16*)(ws + WS_WOUT + l * SZ_WOUT), MTOK, DM, DM}; pg8::StaticOrder S; S.init(MTOK, DM, G, (int)blockIdx.x);
            pg8::EpiRes E{XC, XL, XBUF, MODL + 2 * 2048};
            pg8::gemm_phase<pg8::EpiRes, pg8::StaticOrder, true, true>(lds + RING_OFF, g, S, E); }
            SEAM(pb + 4);
        }
#endif
#ifndef NO_NORM
        if (IN(pb + 5)) { { PHASE_LOCALS norm_phase(XBUF, XBUF + (size_t)NCTX * DM, a.in[10] + l * DM, MODL, 3, 4, HB, gw, NGW, lane); } SEAM(pb + 5); }
#endif
#ifndef NO_G3
        if (IN(pb + 6)) {
            { PHASE_LOCALS
            pg8::Gemm g{HB, (const bf16*)(ws + WS_W1 + l * SZ_W1), MTOK, 2 * DFF, DM}; pg8::StaticOrder S; S.init(MTOK, 2 * DFF, G, (int)blockIdx.x);
            pg8::EpiSwiGLU E{ACTB};
            pg8::gemm_phase<pg8::EpiSwiGLU, pg8::StaticOrder, true, true>(lds + RING_OFF, g, S, E); }
            SEAM(pb + 6);
        }
#endif
#ifndef NO_G4
        if (IN(pb + 7)) {
            { PHASE_LOCALS
            pg8::Gemm g{ACTB, (const bf16*)(ws + WS_W2 + l * SZ_W2), MTOK, DM, DFF}; pg8::StaticOrder S; S.init(MTOK, DM, G, (int)blockIdx.x);
            pg8::EpiRes E{XBUF, XBUF + (size_t)NCTX * DM, XBUF, MODL + 5 * 2048};
            pg8::gemm_phase<pg8::EpiRes, pg8::StaticOrder, true, true>(lds + RING_OFF, g, S, E); }
            SEAM(pb + 7);
        }
#endif
    }
    if (IN(N_PHASES - 1)) { PHASE_LOCALS final_norm_phase(XBUF, a.in[25], a.out + O_YP, gw, NGW, lane); }
#undef IN
#undef SEAM
}

extern "C" void kernel_launch(void* const* d_in, const int* in_sizes, int n_in, void* d_out, int out_size, void* d_ws, size_t ws_size, hipStream_t stream) {
    static int grid = 0;
    if (grid == 0) {
        if (n_in != 26 || (size_t)out_size != O_END || ws_size < WS_END) { fprintf(stderr, "kernel_launch: built for 26 inputs, %zu outputs, >= %zu bytes of workspace; got n_in %d, out %d, ws %zu; nothing launched\n", (size_t)O_END, (size_t)WS_END, n_in, out_size, ws_size); grid = -1; return; }
        int dev = 0, cus = 0, per_cu = 0;
        if (hipGetDevice(&dev) != hipSuccess || hipDeviceGetAttribute(&cus, hipDeviceAttributeMultiprocessorCount, dev) != hipSuccess) { fprintf(stderr, "kernel_launch: device query failed\n"); grid = -1; return; }
        if (hipFuncSetAttribute((const void*)fwd_kernel, hipFuncAttributeMaxDynamicSharedMemorySize, LDS_BYTES) != hipSuccess) { fprintf(stderr, "kernel_launch: hipFuncSetAttribute failed\n"); grid = -1; return; }
        if (hipOccupancyMaxActiveBlocksPerMultiprocessor(&per_cu, (const void*)fwd_kernel, NWAVES * 64, LDS_BYTES) != hipSuccess || per_cu < 1)
            fprintf(stderr, "kernel_launch: note: occupancy query reports %d workgroups per CU\n", per_cu);
        (void)hipGetLastError();
        grid = cus;
    }
    if (grid < 0) return;
    if (hipMemsetAsync((char*)d_ws + WS_CTL, 0, CTL_ZERO_BYTES, stream) != hipSuccess) { fprintf(stderr, "kernel_launch: memset failed\n"); return; }
    Args a{};
    for (int i = 0; i < 26; ++i) a.in[i] = (const float*)d_in[i];
    a.out = (float*)d_out; a.ws = (unsigned char*)d_ws;
#if MK_PER_PHASE
    for (int p = 0; p < N_PHASES; ++p) { a.ph_lo = p; a.ph_hi = p + 1; hipLaunchKernelGGL(fwd_kernel, dim3(grid), dim3(NWAVES * 64), LDS_BYTES, stream, a); }
#else
    a.ph_lo = 0; a.ph_hi = N_PHASES; hipLaunchKernelGGL(fwd_kernel, dim3(grid), dim3(NWAVES * 64), LDS_BYTES, stream, a);
#endif
    const hipError_t le = hipPeekAtLastError();
    if (le != hipSuccess) fprintf(stderr, "kernel_launch: launch failed: %s\n", hipGetErrorName(le));
}
```

```cpp
#include <hip/hip_runtime.h>
#include <cstdio>
#include <cstdint>
namespace pg8 {
#define PG8_LAS __attribute__((address_space(3)))
typedef unsigned short bf16_t;
typedef short bf16x8 __attribute__((ext_vector_type(8)));
typedef float f32x4 __attribute__((ext_vector_type(4)));
typedef unsigned u32x4 __attribute__((ext_vector_type(4)));
constexpr int BM = 256, BK = 64, HALF = 128, HTB = HALF * BK * 2  , STAGE_BYTES = 8 * HTB, NXCD = 8, WGM = 8;

__host__ __device__ __forceinline__ int lds_byte(int r, int c) { const int st = (r >> 4) * 2 + (c >> 5), rr = r & 15, cc = c & 31, ob = rr * 64 + cc * 2; return st * 1024 + (ob ^ (((ob >> 9) & 1) << 5)); }
__host__ __device__ __forceinline__ void stage_rc(int b, int& R, int& C) { const int st = b / 1024, sb = b % 1024, swz = sb ^ (((sb >> 9) & 1) << 5); R = (st >> 1) * 16 + swz / 64; C = (st & 1) * 32 + (swz % 64) / 2; }
__host__ __device__ __forceinline__ int perm32(int rho) { const int n = rho >> 4, i = rho & 15; return 8 * (i >> 2) + 4 * n + (i & 3); }

struct Unit { int pm, pn; };
struct Gemm { const bf16_t* A; const bf16_t* Bt; int M, N, K; };

struct StaticOrder {
    int nM, nN, nwg, G, c;
    __host__ __device__ void init(int M, int N, int G_, int c_) { nM = M / BM; nN = N / BM; nwg = nM * nN; G = G_; c = c_; }
    __host__ __device__ bool next(int i, Unit& u) const {
        const long L = (long)i * G + c; if (L >= nwg) return false;
        int wgid = (int)L; { const int q = nwg / NXCD, r = nwg % NXCD, xcd = wgid % NXCD, off = wgid / NXCD; wgid = (xcd < r ? xcd * (q + 1) : r * (q + 1) + (xcd - r) * q) + off; }
        const int nig = WGM * nN, gid = wgid / nig, fm = gid * WGM, gsz = (nM - fm) < WGM ? (nM - fm) : WGM;
        u.pm = fm + ((wgid % nig) % gsz); u.pn = (wgid % nig) / gsz; return true;
    }
    __device__ __forceinline__ void a_ready(const Unit&) const {}
    __device__ __forceinline__ void done(const Unit&) const {}
};
__device__ __forceinline__ unsigned cvt_pk_bf16(float lo, float hi) { unsigned r; asm volatile("v_cvt_pk_bf16_f32 %0, %1, %2" : "=v"(r) : "v"(lo), "v"(hi)); return r; }
typedef float f32x2 __attribute__((ext_vector_type(2)));
struct EpiIn {
    static constexpr bool PERM = true, AFTER_DRAIN = false;
    bf16_t* P; float* outk; float* outv; const float* rcs; const float* rsn; int layer;
    __device__ __forceinline__ void operator()(const f32x4 (&acc)[2][2][4][2], const Unit& u, int wr, int wc, int fr, int fq) const {
        const bool lat = u.pm >= 32; const bool rope = lat && (u.pn <= 4); const bool kout = (!lat) && (u.pn == 4), vout = (!lat) && (u.pn == 5);
        const int i0 = (wc & 1) * 16 + 4 * fq;
#pragma unroll
        for (int ai = 0; ai < 2; ++ai)
#pragma unroll
            for (int m = 0; m < 4; ++m) {
                const int row = u.pm * BM + ai * HALF + wr * 64 + m * 16 + fr;
                f32x4 cs4 = (f32x4){1.f, 1.f, 1.f, 1.f}, sn4 = (f32x4){0.f, 0.f, 0.f, 0.f};
                if (rope) { const int t = (row - 8192) & 2047; const int p = (wc >> 1) ? (t & 63) : (t >> 6); cs4 = *(const f32x4*)(rcs + p * 32 + i0); sn4 = *(const f32x4*)(rsn + p * 32 + i0); }
#pragma unroll
                for (int bj = 0; bj < 2; ++bj) {
                    f32x4 v0 = acc[ai][bj][m][0], v1 = acc[ai][bj][m][1];
                    if (kout) { float* d = outk + ((size_t)(((row >> 8) * 4 + layer) * 256 + (row & 255)) * 256 + bj * 128 + (wc >> 1) * 64 + (wc & 1) * 16 + 4 * fq);
                        *(f32x4*)d = (f32x4){v0[0], v0[2], v1[0], v1[2]}; *(f32x4*)(d + 32) = (f32x4){v0[1], v0[3], v1[1], v1[3]}; }
                    if (vout) { float* d = outv + ((size_t)(((row >> 8) * 4 + layer) * 256 + (row & 255)) * 256 + bj * 128 + wc * 32 + 8 * fq); *(f32x4*)d = v0; *(f32x4*)(d + 4) = v1; }
                    if (rope) {
                        const f32x4 a0 = v0, a1 = v1;
                        v0[0] = a0[0] * cs4[0] - a0[1] * sn4[0]; v0[1] = a0[1] * cs4[0] + a0[0] * sn4[0];
                        v0[2] = a0[2] * cs4[1] - a0[3] * sn4[1]; v0[3] = a0[3] * cs4[1] + a0[2] * sn4[1];
                        v1[0] = a1[0] * cs4[2] - a1[1] * sn4[2]; v1[1] = a1[1] * cs4[2] + a1[0] * sn4[2];
                        v1[2] = a1[2] * cs4[3] - a1[3] * sn4[3]; v1[3] = a1[3] * cs4[3] + a1[2] * sn4[3];
                    }
                    u32x4 w; w.x = cvt_pk_bf16(v0[0], v0[1]); w.y = cvt_pk_bf16(v0[2], v0[3]); w.z = cvt_pk_bf16(v1[0], v1[1]); w.w = cvt_pk_bf16(v1[2], v1[3]);
                    *(u32x4*)(P + (size_t)row * 3072 + u.pn * BM + bj * HALF + wc * 32 + 8 * fq) = w;
                }
            }
    }
};
struct EpiRes {
    static constexpr bool PERM = false, AFTER_DRAIN = false;
    const float* bctx; const float* blat; float* out; const float* gate;
    __device__ __forceinline__ void operator()(const f32x4 (&acc)[2][2][4][2], const Unit& u, int wr, int wc, int fr, int fq) const {
        const int cond = u.pm < 32 ? 0 : (u.pm < 40 ? 1 : 2);
        const float* g = gate + cond * 12288; const float* bs = u.pm < 32 ? bctx : blat - (size_t)8192 * 2048;
        const int col0 = u.pn * BM + wc * 32 + 4 * fq;
        f32x4 gv[2][2];
#pragma unroll
        for (int bj = 0; bj < 2; ++bj)
#pragma unroll
            for (int n = 0; n < 2; ++n) gv[bj][n] = *(const f32x4*)(g + col0 + bj * HALF + n * 16);
#pragma unroll
        for (int ai = 0; ai < 2; ++ai)
#pragma unroll
            for (int m = 0; m < 4; ++m) { const size_t off = (size_t)(u.pm * BM + ai * HALF + wr * 64 + m * 16 + fr) * 2048 + col0;
#pragma unroll
                for (int bj = 0; bj < 2; ++bj)
#pragma unroll
                    for (int n = 0; n < 2; ++n) { const f32x4 b = *(const f32x4*)(bs + off + bj * HALF + n * 16); *(f32x4*)(out + off + bj * HALF + n * 16) = b + gv[bj][n] * acc[ai][bj][m][n]; }
            }
    }
};
struct EpiSwiGLU {
    static constexpr bool PERM = true, AFTER_DRAIN = false;
    bf16_t* act;
    __device__ __forceinline__ float sl(float g, float u) const { return g * u * __builtin_amdgcn_rcpf(1.0f + __builtin_amdgcn_exp2f(-1.4426950408889634f * g)); }
    __device__ __forceinline__ void operator()(const f32x4 (&acc)[2][2][4][2], const Unit& u, int wr, int wc, int fr, int fq) const {
#pragma unroll
        for (int ai = 0; ai < 2; ++ai)
#pragma unroll
            for (int m = 0; m < 4; ++m) { const int row = u.pm * BM + ai * HALF + wr * 64 + m * 16 + fr;
                const f32x4 g0 = acc[ai][0][m][0], g1 = acc[ai][0][m][1], u0 = acc[ai][1][m][0], u1 = acc[ai][1][m][1];
                u32x4 w; w.x = cvt_pk_bf16(sl(g0[0], u0[0]), sl(g0[1], u0[1])); w.y = cvt_pk_bf16(sl(g0[2], u0[2]), sl(g0[3], u0[3]));
                w.z = cvt_pk_bf16(sl(g1[0], u1[0]), sl(g1[1], u1[1])); w.w = cvt_pk_bf16(sl(g1[2], u1[2]), sl(g1[3], u1[3]));
                *(u32x4*)(act + (size_t)row * 5632 + u.pn * HALF + wc * 32 + 8 * fq) = w; }
    }
};
template <class Epi, class Sched, bool ALIGN_EPI = false, bool SP2 = false>
__device__ __forceinline__ void gemm_phase(PG8_LAS unsigned char* lds, const Gemm g, const Sched& S, const Epi& E) {
    int tid_ = threadIdx.x; asm volatile("" : "+v"(tid_));
    const int tid = tid_, wid = __builtin_amdgcn_readfirstlane(tid >> 6), lane = tid & 63, wr = wid >> 2, wc = wid & 3, fr = lane & 15, fq = lane >> 4;
    const int K = g.K, nt = K / BK;
    unsigned voffA[2], voffB[2];
#pragma unroll
    for (int i = 0; i < 2; ++i) { int R, C; stage_rc(tid * 16 + i * 8192, R, C); const int Rb = Epi::PERM ? ((R & ~31) + perm32(R & 31)) : R;
        voffA[i] = (unsigned)(R * K + C) * 2u; voffB[i] = (unsigned)(Rb * K + C) * 2u; }
    const size_t kstep = (size_t)(BK * 2);
    const size_t hstep = (size_t)HALF * K * 2;
    const size_t tstep = 2 * hstep;
    const unsigned ldsw = (unsigned)wid * 1024u;
    const int aoff = lds_byte(wr * 64 + fr, fq * 8), boff = lds_byte(wc * 32 + fr, fq * 8);
#define PG8_SA(b, h) (((b) * 2 + (h)) * HTB)
#define PG8_SB(b, h) ((4 + (b) * 2 + (h)) * HTB)
#define PG8_STAGE(bufoff, gbase, voff) do { _Pragma("unroll") for (int _i = 0; _i < 2; ++_i) \
        __builtin_amdgcn_global_load_lds((const unsigned*)((const char*)(gbase) + (voff)[_i]), (PG8_LAS unsigned*)(lds + (bufoff) + ldsw + _i * 8192), 16, 0, 0); } while (0)
#define PG8_LDA(dst, b, h) do { _Pragma("unroll") for (int m = 0; m < 4; ++m) _Pragma("unroll") for (int k = 0; k < 2; ++k) dst[m][k] = *(const PG8_LAS bf16x8*)(lds + PG8_SA(b, h) + aoff + m * 2048 + k * 1024); } while (0)
#define PG8_LDB(dst, b, h) do { _Pragma("unroll") for (int n = 0; n < 2; ++n) _Pragma("unroll") for (int k = 0; k < 2; ++k) dst[n][k] = *(const PG8_LAS bf16x8*)(lds + PG8_SB(b, h) + boff + n * 2048 + k * 1024); } while (0)
#define PG8_MMA(ai, bj, At, Bt) do { __builtin_amdgcn_s_setprio(1); _Pragma("unroll") for (int m = 0; m < 4; ++m) _Pragma("unroll") for (int n = 0; n < 2; ++n) _Pragma("unroll") for (int k = 0; k < 2; ++k) \
        acc[ai][bj][m][n] = __builtin_amdgcn_mfma_f32_16x16x32_bf16(Bt[n][k], At[m][k], acc[ai][bj][m][n], 0, 0, 0); __builtin_amdgcn_s_setprio(0); } while (0)
#define PG8_WAIT_V(n) asm volatile("s_waitcnt vmcnt(" #n ")" ::: "memory")
#define PG8_WAIT_L(n) asm volatile("s_waitcnt lgkmcnt(" #n ")" ::: "memory")
#define PG8_BAR __builtin_amdgcn_s_barrier()
#define PG8_SCHED __builtin_amdgcn_sched_barrier(0)
    Unit cur, nxt; int ui = 0;
    if (!S.next(0, cur)) return;
    f32x4 acc[2][2][4][2];
#pragma unroll
    for (int a = 0; a < 2; ++a)
#pragma unroll
        for (int b = 0; b < 2; ++b)
#pragma unroll
            for (int m = 0; m < 4; ++m)
#pragma unroll
                for (int n = 0; n < 2; ++n) acc[a][b][m][n] = (f32x4){0.f, 0.f, 0.f, 0.f};
    bf16x8 At[4][2], B0[2][2], B1[2][2];
    const char* cA = (const char*)g.A + (size_t)cur.pm * tstep; const char* cB = (const char*)g.Bt + (size_t)cur.pn * tstep;
    S.a_ready(cur);
    if constexpr (SP2) {
        PG8_STAGE(PG8_SB(0, 0), cB, voffB); PG8_STAGE(PG8_SB(0, 1), cB + hstep, voffB); PG8_STAGE(PG8_SA(0, 0), cA, voffA); PG8_STAGE(PG8_SA(0, 1), cA + hstep, voffA);
        if (wr == 1) PG8_BAR;
        PG8_WAIT_V(2); PG8_BAR;
        PG8_STAGE(PG8_SB(1, 0), cB + kstep, voffB); PG8_STAGE(PG8_SA(1, 0), cA + kstep, voffA); PG8_STAGE(PG8_SB(1, 1), cB + hstep + kstep, voffB);
        PG8_WAIT_V(6); PG8_BAR;
    } else {
        PG8_STAGE(PG8_SB(0, 0), cB, voffB); PG8_STAGE(PG8_SA(0, 0), cA, voffA); PG8_STAGE(PG8_SB(0, 1), cB + hstep, voffB); PG8_STAGE(PG8_SA(0, 1), cA + hstep, voffA);
        if (wr == 1) PG8_BAR;
        PG8_WAIT_V(4); PG8_BAR;
        PG8_STAGE(PG8_SB(1, 0), cB + kstep, voffB); PG8_STAGE(PG8_SA(1, 0), cA + kstep, voffA); PG8_STAGE(PG8_SB(1, 1), cB + hstep + kstep, voffB);
        PG8_WAIT_V(6); PG8_BAR;
    }
    for (;;) {
        const bool has_next = S.next(ui + 1, nxt);
        const char* nA = has_next ? (const char*)g.A + (size_t)nxt.pm * tstep : cA; const char* nB = has_next ? (const char*)g.Bt + (size_t)nxt.pn * tstep : cB;
        for (int t = 0; t < nt; t += 2) {
            const bool last = (t == nt - 2);
            const char* a1 = cA + (size_t)(t + 1) * kstep;
            const char* a2 = last ? nA : cA + (size_t)(t + 2) * kstep; const char* b2 = last ? nB : cB + (size_t)(t + 2) * kstep;
            const char* a3 = a2 + kstep; const char* b3 = b2 + kstep;
            if (last && has_next) S.a_ready(nxt);
            if constexpr (SP2) {
            PG8_LDB(B0, 0, 0); PG8_LDB(B1, 0, 1); PG8_SCHED; PG8_LDA(At, 0, 0); PG8_STAGE(PG8_SA(1, 1), a1 + hstep, voffA);
            PG8_WAIT_V(8); PG8_WAIT_L(0); PG8_BAR; PG8_MMA(0, 0, At, B0); PG8_MMA(0, 1, At, B1); PG8_BAR; PG8_SCHED;
            PG8_LDA(At, 0, 1); PG8_STAGE(PG8_SB(0, 0), b2, voffB); PG8_STAGE(PG8_SB(0, 1), b2 + hstep, voffB); PG8_STAGE(PG8_SA(0, 0), a2, voffA);
            PG8_WAIT_V(8); PG8_WAIT_L(0); PG8_BAR; PG8_MMA(1, 0, At, B0); PG8_MMA(1, 1, At, B1); PG8_BAR; PG8_SCHED;
            PG8_LDB(B0, 1, 0); PG8_LDB(B1, 1, 1); PG8_SCHED; PG8_LDA(At, 1, 0); PG8_STAGE(PG8_SA(0, 1), a2 + hstep, voffA);
            PG8_WAIT_V(8); PG8_WAIT_L(0); PG8_BAR; PG8_MMA(0, 0, At, B0); PG8_MMA(0, 1, At, B1); PG8_BAR; PG8_SCHED;
            PG8_LDA(At, 1, 1); PG8_STAGE(PG8_SB(1, 0), b3, voffB); PG8_STAGE(PG8_SB(1, 1), b3 + hstep, voffB); PG8_STAGE(PG8_SA(1, 0), a3, voffA);
            PG8_WAIT_V(8); PG8_WAIT_L(0); PG8_BAR; PG8_MMA(1, 0, At, B0); PG8_MMA(1, 1, At, B1); PG8_BAR; PG8_SCHED;
            } else {
            PG8_LDB(B0, 0, 0); PG8_SCHED; PG8_LDA(At, 0, 0); PG8_STAGE(PG8_SA(1, 1), a1 + hstep, voffA);
            PG8_WAIT_L(8); PG8_BAR; PG8_WAIT_L(0); PG8_MMA(0, 0, At, B0); PG8_BAR; PG8_SCHED;
            PG8_LDB(B1, 0, 1); PG8_STAGE(PG8_SB(0, 0), b2, voffB);
            PG8_BAR; PG8_WAIT_L(0); PG8_MMA(0, 1, At, B1); PG8_BAR;
            PG8_LDA(At, 0, 1); PG8_STAGE(PG8_SA(0, 0), a2, voffA);
            PG8_BAR; PG8_WAIT_L(0); PG8_MMA(1, 0, At, B0); PG8_BAR; PG8_SCHED;
            PG8_STAGE(PG8_SB(0, 1), b2 + hstep, voffB);
            PG8_WAIT_V(6); PG8_BAR; PG8_MMA(1, 1, At, B1); PG8_BAR;
            PG8_LDB(B0, 1, 0); PG8_SCHED; PG8_LDA(At, 1, 0); PG8_STAGE(PG8_SA(0, 1), a2 + hstep, voffA);
            PG8_WAIT_L(8); PG8_BAR; PG8_WAIT_L(0); PG8_MMA(0, 0, At, B0); PG8_BAR; PG8_SCHED;
            PG8_LDB(B1, 1, 1); PG8_STAGE(PG8_SB(1, 0), b3, voffB);
            PG8_BAR; PG8_WAIT_L(0); PG8_MMA(0, 1, At, B1); PG8_BAR;
            PG8_LDA(At, 1, 1); PG8_STAGE(PG8_SA(1, 0), a3, voffA);
            PG8_BAR; PG8_WAIT_L(0); PG8_MMA(1, 0, At, B0); PG8_BAR; PG8_SCHED;
            PG8_STAGE(PG8_SB(1, 1), b3 + hstep, voffB);
            PG8_WAIT_V(6); PG8_BAR; PG8_MMA(1, 1, At, B1); PG8_BAR;
            }
        }
        if constexpr (ALIGN_EPI) { if (wr == 0) PG8_BAR; }
        if constexpr (!Epi::AFTER_DRAIN) { E(acc, cur, wr, wc, fr, fq); S.done(cur); }
        if (!has_next) break;
#pragma unroll
        for (int a = 0; a < 2; ++a)
#pragma unroll
            for (int b = 0; b < 2; ++b)
#pragma unroll
                for (int m = 0; m < 4; ++m)
#pragma unroll
                    for (int n = 0; n < 2; ++n) acc[a][b][m][n] = (f32x4){0.f, 0.f, 0.f, 0.f};
        cur = nxt; cA = nA; cB = nB; ++ui;
        if constexpr (ALIGN_EPI) { if (wr == 1) PG8_BAR; }
    }
    PG8_WAIT_V(0);
    if constexpr (!ALIGN_EPI) { if (wr == 0) PG8_BAR; }
    PG8_BAR;
    if constexpr (Epi::AFTER_DRAIN) { E.fused(acc, cur, wr, wc, fr, fq, lds, wid, lane); S.done(cur); }
#undef PG8_SA
#undef PG8_SB
#undef PG8_STAGE
#undef PG8_LDA
#undef PG8_LDB
#undef PG8_MMA
#undef PG8_WAIT_V
#undef PG8_WAIT_L
#undef PG8_BAR
#undef PG8_SCHED
}
}
namespace att {
typedef unsigned short bf16;
using bf16x8 = __attribute__((ext_vector_type(8))) short;
using s16x4  = __attribute__((ext_vector_type(4))) short;
using f32x16 = __attribute__((ext_vector_type(16))) float;
using u32x4  = __attribute__((ext_vector_type(4))) unsigned;
constexpr int   D = 128, NW = 8, QBLK = 32, KVBLK = 64;
constexpr float SCALE = 0.088388347648318440f;
constexpr float THR = 8.f;
#ifndef ATT_SDEPTH
#define ATT_SDEPTH 1
#endif
constexpr int SDEPTH = ATT_SDEPTH;
constexpr size_t SHM_V = KVBLK * D * 2, SHM_K = KVBLK * D * 2, SHM_ATTN = 2 * SHM_V + 2 * SHM_K + NW * 64 * 4;
#define KSWZ(row, colB) ((row) * 256 + ((colB) ^ (((row) & 7) << 4)))
#define SBAR() __builtin_amdgcn_sched_barrier(0)
__device__ __forceinline__ int crow(int r, int hi) { return (r & 3) + 8 * (r >> 2) + 4 * hi; }
__device__ __forceinline__ unsigned cvtpk(float lo, float hi) { unsigned r; asm volatile("v_cvt_pk_bf16_f32 %0, %1, %2" : "=v"(r) : "v"(lo), "v"(hi)); return r; }
__device__ __forceinline__ bf16x8 ld8(const bf16* p) { return *reinterpret_cast<const bf16x8*>(p); }

__device__ __forceinline__ void partialSM(f32x16& p0, f32x16& p1, float& m_reg, float& mn, float& alpha) {
  constexpr float C = SCALE * 1.4426950408889634f;
  float pmax = p0[0];
#pragma unroll
  for (int r = 1; r < 16; ++r) pmax = fmaxf(pmax, p0[r]);
#pragma unroll
  for (int r = 0; r < 16; ++r) pmax = fmaxf(pmax, p1[r]);
  { auto rr = __builtin_amdgcn_permlane32_swap(__float_as_uint(pmax), __float_as_uint(pmax), false, false);
    pmax = fmaxf(__uint_as_float(rr[0]), __uint_as_float(rr[1])); }
  if (__builtin_expect(__all(pmax - m_reg <= THR / SCALE), 1)) { mn = m_reg; alpha = 1.f; }
  else { mn = fmaxf(m_reg, pmax); alpha = __builtin_amdgcn_exp2f((m_reg - mn) * C); m_reg = mn; }
  float mnC = -mn * C;
#pragma unroll
  for (int r = 0; r < 16; ++r) p0[r] = fmaf(p0[r], C, mnC);
#pragma unroll
  for (int r = 0; r < 16; ++r) p1[r] = fmaf(p1[r], C, mnC);
#pragma unroll
  for (int r = 0; r < 16; ++r) p0[r] = __builtin_amdgcn_exp2f(p0[r]);
}
__device__ __forceinline__ void finishSM(f32x16& p0, f32x16& p1, float alpha, float& l_reg, bf16x8& pa0, bf16x8& pa1, bf16x8& pa2, bf16x8& pa3) {
#pragma unroll
  for (int r = 0; r < 16; ++r) p1[r] = __builtin_amdgcn_exp2f(p1[r]);
  float ps = 0;
#pragma unroll
  for (int r = 0; r < 16; ++r) ps += p0[r];
#pragma unroll
  for (int r = 0; r < 16; ++r) ps += p1[r];
  { auto rr = __builtin_amdgcn_permlane32_swap(__float_as_uint(ps), __float_as_uint(ps), false, false);
    ps = __uint_as_float(rr[0]) + __uint_as_float(rr[1]); }
  l_reg = l_reg * alpha + ps;
#define PK4(P, BASE, OUT) do { unsigned a0 = cvtpk(P[BASE + 0], P[BASE + 1]), a1 = cvtpk(P[BASE + 2], P[BASE + 3]);   \
    unsigned b0 = cvtpk(P[BASE + 4], P[BASE + 5]), b1 = cvtpk(P[BASE + 6], P[BASE + 7]);                              \
    auto r0 = __builtin_amdgcn_permlane32_swap(a0, b0, false, false); auto r1 = __builtin_amdgcn_permlane32_swap(a1, b1, false, false); \
    u32x4 w = {r0[0], r1[0], r0[1], r1[1]}; OUT = *reinterpret_cast<bf16x8*>(&w); } while (0)
  PK4(p0, 0, pa0); PK4(p0, 8, pa1); PK4(p1, 0, pa2); PK4(p1, 8, pa3);
#undef PK4
}
__device__ __forceinline__ void qkt(f32x16& p0, f32x16& p1, const bf16* Ks, const bf16x8* qr, int r32, int hi) {
  p0 = f32x16{}; p1 = f32x16{};
#pragma unroll
  for (int d0 = 0; d0 < 8; ++d0) { int cb = (d0 * 16 + hi * 8) * 2;
    bf16x8 b0 = *reinterpret_cast<const bf16x8*>((const char*)Ks + KSWZ(r32, cb));
    bf16x8 b1 = *reinterpret_cast<const bf16x8*>((const char*)Ks + KSWZ(32 + r32, cb));
    p0 = __builtin_amdgcn_mfma_f32_32x32x16_bf16(b0, qr[d0], p0, 0, 0, 0);
    p1 = __builtin_amdgcn_mfma_f32_32x32x16_bf16(b1, qr[d0], p1, 0, 0, 0); }
}
__device__ __forceinline__ void band_mask(f32x16& p0, f32x16& p1, int base, int hi) {
#pragma unroll
  for (int r = 0; r < 16; ++r) { const int kv = crow(r, hi); if ((unsigned)(base - kv) > 256u) p0[r] = -1e30f; if ((unsigned)(base - kv - 32) > 256u) p1[r] = -1e30f; }
}
__device__ __forceinline__ int v_st(int k, int c) { const int kk = (k & ~0xC) | ((k & 4) << 1) | ((k & 8) >> 1); return ((kk >> 3) * 4 + (c >> 5)) * 512 + ((kk & 7) * 32 + (c & 31)) * 2; }
__device__ __forceinline__ int v_rd_base(int lane) { return ((lane & 3) << 3) | (((lane >> 2) & 3) << 6) | (((lane >> 4) & 1) << 5) | (((lane >> 5) & 1) << 8); }
constexpr int v_rd_off(int d0, int ks, int half) { return d0 * 512 + ks * 4096 + half * 2048; }
template <int OFF> __device__ __forceinline__ s16x4 tr_read(int vb) {
  s16x4 r; asm volatile("ds_read_b64_tr_b16 %0, %1 offset:%2" : "=&v"(r) : "v"(vb), "i"(OFF) : "memory"); return r;
}
template <int D0> __device__ __forceinline__ void pv_one(f32x16& od, int vb, bf16x8 pa0, bf16x8 pa1, bf16x8 pa2, bf16x8 pa3) {
  const s16x4 l0 = tr_read<v_rd_off(D0, 0, 0)>(vb), h0 = tr_read<v_rd_off(D0, 0, 1)>(vb), l1 = tr_read<v_rd_off(D0, 1, 0)>(vb), h1 = tr_read<v_rd_off(D0, 1, 1)>(vb);
  const s16x4 l2 = tr_read<v_rd_off(D0, 2, 0)>(vb), h2 = tr_read<v_rd_off(D0, 2, 1)>(vb), l3 = tr_read<v_rd_off(D0, 3, 0)>(vb), h3 = tr_read<v_rd_off(D0, 3, 1)>(vb);
  asm volatile("s_waitcnt lgkmcnt(0)" ::: "memory"); SBAR();
#define PK(L, H) (bf16x8){L[0], L[1], L[2], L[3], H[0], H[1], H[2], H[3]}
  od = __builtin_amdgcn_mfma_f32_32x32x16_bf16(pa0, PK(l0, h0), od, 0, 0, 0);
  od = __builtin_amdgcn_mfma_f32_32x32x16_bf16(pa1, PK(l1, h1), od, 0, 0, 0);
  od = __builtin_amdgcn_mfma_f32_32x32x16_bf16(pa2, PK(l2, h2), od, 0, 0, 0);
  od = __builtin_amdgcn_mfma_f32_32x32x16_bf16(pa3, PK(l3, h3), od, 0, 0, 0);
#undef PK
}
__device__ __forceinline__ void pv_d0(f32x16* o, int vb, bf16x8 pa0, bf16x8 pa1, bf16x8 pa2, bf16x8 pa3) {
  pv_one<0>(o[0], vb, pa0, pa1, pa2, pa3); pv_one<1>(o[1], vb, pa0, pa1, pa2, pa3); pv_one<2>(o[2], vb, pa0, pa1, pa2, pa3); pv_one<3>(o[3], vb, pa0, pa1, pa2, pa3);
}
struct Src { const bf16* k0; const bf16* v0; int ld0; int n0; const bf16* k1; const bf16* v1; int ld1; int nt; int jb_lo; };

template <bool MASKED>
__device__ __forceinline__ void attn_unit(const bf16* __restrict__ Qb, int ldq, const Src S, float sinkv, bf16* __restrict__ Ob, int ldo, char* lds) {
  int tid_ = threadIdx.x; asm volatile("" : "+v"(tid_));
  const int tid = tid_, wid = tid >> 6, lane = tid & 63, r32 = lane & 31, hi = lane >> 5;
  bf16* V_lds = (bf16*)lds; bf16* K_lds = (bf16*)(lds + 2 * SHM_V);
  float* ws = (float*)(lds + 2 * SHM_V + 2 * SHM_K) + wid * 64; float* li_l = ws; float* al_l = ws + 32;
  float m_reg = -1e30f, l_reg = 0; f32x16 o[4] = {}; bf16x8 qr[8];
  const bf16* Qw = Qb + (long)(wid * QBLK + r32) * ldq + hi * 8;
#pragma unroll
  for (int d0 = 0; d0 < 8; ++d0) qr[d0] = ld8(Qw + d0 * 16);
  const int sr = tid >> 4, sc = (tid & 15) * 8, vst0 = v_st(sr, sc), vst1 = v_st(32 + sr, sc);
  const int vb0 = (int)(uintptr_t)V_lds + v_rd_base(lane);
  const int mbase = wid * QBLK + r32 + 256;
  const unsigned voff0 = (unsigned)(sr * S.ld0 + sc), voff1 = (unsigned)(sr * S.ld1 + sc);
  struct { bf16x8 vs0, vs1, ks0, ks1; } sr_[SDEPTH];
#define SLOAD(i, j) do { const int j_ = (j); const bool s0_ = j_ < S.n0; const int ld_ = s0_ ? S.ld0 : S.ld1; const long ro_ = (long)(s0_ ? j_ : j_ - S.n0) * KVBLK * ld_; \
    const bf16* kp_ = (s0_ ? S.k0 : S.k1) + ro_; const bf16* vp_ = (s0_ ? S.v0 : S.v1) + ro_; const bf16* kq_ = kp_ + 32l * ld_; const bf16* vq_ = vp_ + 32l * ld_; const unsigned vo_ = s0_ ? voff0 : voff1; \
    sr_[i].vs0 = ld8(vp_ + vo_); sr_[i].vs1 = ld8(vq_ + vo_); sr_[i].ks0 = ld8(kp_ + vo_); sr_[i].ks1 = ld8(kq_ + vo_); } while (0)
#define SWRITE(b, i) do { *(bf16x8*)((char*)V_lds + (b) * SHM_V + vst0) = sr_[i].vs0;          \
    *(bf16x8*)((char*)V_lds + (b) * SHM_V + vst1) = sr_[i].vs1; int kc = sc * 2;               \
    *(bf16x8*)((char*)K_lds + (b) * SHM_K + KSWZ(sr, kc)) = sr_[i].ks0;                       \
    *(bf16x8*)((char*)K_lds + (b) * SHM_K + KSWZ(32 + sr, kc)) = sr_[i].ks1; } while (0)
#define SWAIT() do { if constexpr (SDEPTH == 2) asm volatile("s_waitcnt vmcnt(4)" ::: "memory"); else asm volatile("s_waitcnt vmcnt(0)" ::: "memory"); } while (0)
#define RESC(a) do { if (__any((a) < 1.f)) { if (hi == 0) al_l[r32] = (a); asm volatile("s_waitcnt lgkmcnt(0)" ::: "memory"); \
    _Pragma("unroll") for (int d = 0; d < 4; ++d) _Pragma("unroll") for (int r = 0; r < 16; ++r) o[d][r] *= al_l[crow(r, hi)]; } } while (0)
#define MASK(P0, P1, j) do { if (MASKED) { const int j_ = (j); if (j_ >= S.n0) band_mask(P0, P1, mbase - 64 * (S.jb_lo + j_ - S.n0), hi); } } while (0)
  f32x16 pA0, pA1, pB0, pB1; float mnA, mnB, alA, alB; bf16x8 pa0, pa1, pa2, pa3; const int NT = S.nt;
  constexpr int SE = 0, SO = SDEPTH - 1;
  SLOAD(SE, 0); asm volatile("s_waitcnt vmcnt(0)" ::: "memory"); SWRITE(0, SE); __syncthreads();
  qkt(pA0, pA1, K_lds, qr, r32, hi); MASK(pA0, pA1, 0); partialSM(pA0, pA1, m_reg, mnA, alA);
  SLOAD(SO, 1); if constexpr (SDEPTH == 2) { if (2 < NT) SLOAD(SE, 2); }
  SWAIT(); SWRITE(1, SO); __syncthreads();
  for (int j = 1; j + 1 < NT; j += 2) {
    SBAR(); qkt(pB0, pB1, (bf16*)((char*)K_lds + SHM_K), qr, r32, hi); MASK(pB0, pB1, j);
    finishSM(pA0, pA1, alA, l_reg, pa0, pa1, pa2, pa3); SBAR();
    SLOAD(SO, j + SDEPTH); SBAR();
    pv_d0(o, vb0, pa0, pa1, pa2, pa3); partialSM(pB0, pB1, m_reg, mnB, alB);
    __syncthreads(); SWAIT(); SWRITE(0, SE);
    RESC(alB); __syncthreads();
    SBAR(); qkt(pA0, pA1, K_lds, qr, r32, hi); MASK(pA0, pA1, j + 1);
    finishSM(pB0, pB1, alB, l_reg, pa0, pa1, pa2, pa3); SBAR();
    if (SDEPTH == 1 || j + 3 < NT) SLOAD(SE, j + 1 + SDEPTH); SBAR();
    pv_d0(o, vb0 + (int)SHM_V, pa0, pa1, pa2, pa3); partialSM(pA0, pA1, m_reg, mnA, alA);
    __syncthreads(); SWAIT(); SWRITE(1, SO);
    RESC(alA); __syncthreads();
  }
  SBAR(); qkt(pB0, pB1, (bf16*)((char*)K_lds + SHM_K), qr, r32, hi); MASK(pB0, pB1, NT - 1);
  finishSM(pA0, pA1, alA, l_reg, pa0, pa1, pa2, pa3); SBAR();
  pv_d0(o, vb0, pa0, pa1, pa2, pa3); partialSM(pB0, pB1, m_reg, mnB, alB);
  __syncthreads(); RESC(alB);
  finishSM(pB0, pB1, alB, l_reg, pa0, pa1, pa2, pa3); SBAR();
  pv_d0(o, vb0 + (int)SHM_V, pa0, pa1, pa2, pa3);
  l_reg += __builtin_amdgcn_exp2f(sinkv * 1.4426950408889634f - m_reg * (SCALE * 1.4426950408889634f));
  if (hi == 0) li_l[r32] = l_reg; asm volatile("s_waitcnt lgkmcnt(0)" ::: "memory");
  float rli[16];
#pragma unroll
  for (int r = 0; r < 16; ++r) rli[r] = __builtin_amdgcn_rcpf(li_l[crow(r, hi)]);
  bf16* Ow = Ob + (long)(wid * QBLK) * ldo;
#pragma unroll
  for (int r = 0; r < 16; ++r) { const int orow = crow(r, hi);
#pragma unroll
    for (int d0 = 0; d0 < 4; ++d0) { const float v = o[d0][r] * rli[r]; const unsigned ub = __float_as_uint(v); Ow[(long)orow * ldo + d0 * 32 + r32] = (bf16)((ub + 0x7fffu + ((ub >> 16) & 1u)) >> 16); } }
  __syncthreads();
#undef SLOAD
#undef SWRITE
#undef SWAIT
#undef RESC
#undef MASK
}
#undef KSWZ
#undef SBAR
}
constexpr int NWAVES = 8;
constexpr int DM = 2048, NCTX = 8192, NLAT = 4096, MTOK = NCTX + NLAT, DEPTH = 4, DIN = 3072, DFF = 5632, DLRU = 512;
constexpr size_t O_YP = 0, O_YS = (size_t)NCTX * DM, O_CK = O_YS + (size_t)NLAT * DM, O_CV = O_CK + (size_t)32 * 4 * 256 * 256, O_ST = O_CV + (size_t)32 * 4 * 256 * 256, O_END = O_ST + (size_t)32 * 4 * 2 * 512;
#ifndef MK_PER_PHASE
#define MK_PER_PHASE 0
#endif
constexpr size_t MiB = 1u << 20;
constexpr size_t al(size_t x) { return (x + MiB - 1) / MiB * MiB; }
constexpr size_t WS_CTL = 0, CTL_ZERO_BYTES = 1 * MiB;
constexpr size_t SZ_WIN = (size_t)DIN * DM * 2, SZ_WOUT = (size_t)DM * DM * 2, SZ_W1 = (size_t)2 * DFF * DM * 2, SZ_W2 = (size_t)DM * DFF * 2;
constexpr size_t WS_WIN = 1 * MiB, WS_WOUT = WS_WIN + al(DEPTH * SZ_WIN), WS_W1 = WS_WOUT + al(DEPTH * SZ_WOUT), WS_W2 = WS_W1 + al(DEPTH * SZ_W1);
constexpr size_t WS_GW = WS_W2 + al(DEPTH * SZ_W2);
constexpr size_t WS_PW = WS_GW + al((size_t)DEPTH * 2 * 2 * 512 * 128 * 2);
constexpr size_t WS_CKB = WS_PW + al((size_t)DEPTH * 4 * 128 * 128 * 2);
constexpr size_t WS_CVB = WS_CKB + al((size_t)2 * 4 * 512 * 256 * 2);
constexpr size_t WS_MODP = WS_CVB + al((size_t)2 * 4 * 512 * 256 * 2);
constexpr size_t WS_MODV = WS_MODP + al((size_t)16 * 4 * 3 * 12288 * 4);
constexpr size_t WS_ROPE = WS_MODV + al((size_t)4 * 3 * 12288 * 4);
constexpr size_t WS_SUMM = WS_ROPE + 1 * MiB;
constexpr size_t WS_X = WS_SUMM + al((size_t)192 * 2 * 512 * 8);
constexpr size_t WS_H = WS_X + al((size_t)MTOK * DM * 4);
constexpr size_t WS_P = WS_H + al((size_t)MTOK * DM * 2);
constexpr size_t WS_MIX = WS_P + al((size_t)MTOK * DIN * 2);
constexpr size_t WS_ACT = WS_MIX + al((size_t)MTOK * DM * 2);
constexpr size_t WS_END = WS_ACT + al((size_t)MTOK * DFF * 2);
constexpr int CW_TMO = 0, CW_BAR = 4096;
constexpr int RING_OFF = 0, RING_BYTES = 131072;
constexpr int LDSCTL_OFF = RING_BYTES, MISC_OFF = LDSCTL_OFF + 320;
constexpr int LDS_BYTES = 147456;

#define GAS __attribute__((address_space(1)))
#define LAS __attribute__((address_space(3)))
typedef unsigned short bf16;
typedef unsigned v4u __attribute__((ext_vector_type(4)));
typedef float f32x4 __attribute__((ext_vector_type(4)));
typedef short bf16x8 __attribute__((ext_vector_type(8)));
#define LDS_WAIT() asm volatile("s_waitcnt lgkmcnt(0)" ::: "memory")
__device__ __forceinline__ unsigned f2bf(float f) { unsigned u = __builtin_bit_cast(unsigned, f); return (u + 0x7fffu + ((u >> 16) & 1u)) >> 16; }
__device__ __forceinline__ unsigned pk2(float lo, float hi) { return f2bf(lo) | (f2bf(hi) << 16); }
__device__ __forceinline__ float bf2f(unsigned short h) { return __uint_as_float((unsigned)h << 16); }
__device__ __forceinline__ float sigmoidf_(float x) { return __builtin_amdgcn_rcpf(1.0f + __builtin_amdgcn_exp2f(-1.4426950408889634f * x)); }
__device__ __forceinline__ float wave_sum(float v) {
#pragma unroll
    for (int o = 1; o < 64; o <<= 1) v += __shfl_xor(v, o);
    return v;
}
#define XB_TMO      128
#define XB_XCNT(j)  (256  + 64 * (j))
#define XB_XSUB(j)  (1280 + 64 * (j))
#define XB_XGEN(j)  (2304 + 64 * (j))
#define XB_TOP      3328
#define XB_TOPGEN   3392
#define XCD_BAR_WORDS 3456
#define XB_SPIN_CAP (1u << 18)

__device__ __forceinline__ unsigned xb_ld(unsigned* p)              { return __hip_atomic_load(p, __ATOMIC_RELAXED, __HIP_MEMORY_SCOPE_AGENT); }
__device__ __forceinline__ unsigned xb_add(unsigned* p, unsigned v) { return __hip_atomic_fetch_add(p, v, __ATOMIC_RELAXED, __HIP_MEMORY_SCOPE_AGENT); }
__device__ __forceinline__ unsigned xb_xcc_id() { return (unsigned)__builtin_amdgcn_s_getreg((3 << 11) | 20) & 0xFu; }
#define XB_SPIN(cond, bar) do { unsigned _sp = 0; while (cond) { __builtin_amdgcn_s_sleep(1); \
    if ((++_sp & 255u) == 0u) { if (xb_ld(&(bar)[XB_TMO])) break; if (_sp > XB_SPIN_CAP) { atomicAdd(&(bar)[XB_TMO], 1u); break; } } } } while (0)

struct XcdBarrier {
    unsigned* bar; unsigned x;
    volatile LAS unsigned* st;
};

__device__ __forceinline__ XcdBarrier xcd_barrier_post(unsigned* bar, volatile LAS unsigned* st) {
    XcdBarrier b; b.bar = bar; b.x = xb_xcc_id(); b.st = st;
    if (threadIdx.x == 0) (void)xb_add(&bar[XB_XCNT(b.x)], 1u);
    return b;
}
__device__ __forceinline__ void xcd_barrier_complete(unsigned* bar, unsigned x, unsigned& nloc, unsigned& nx) {
    const unsigned G = gridDim.x * gridDim.y * gridDim.z;
    unsigned sum, cnt, mine, sp = 0u;
    for (;;) {
        sum = 0u; cnt = 0u; mine = 0u;
#pragma unroll
        for (unsigned j = 0; j < 16; ++j) { const unsigned c = xb_ld(&bar[XB_XCNT(j)]); sum += c; cnt += (c > 0u) ? 1u : 0u; mine = (j == x) ? c : mine; }
        if (sum == G) break;
        __builtin_amdgcn_s_sleep(1);
        if ((++sp & 255u) == 0u) { if (xb_ld(&bar[XB_TMO])) break; if (sp > XB_SPIN_CAP) { atomicAdd(&bar[XB_TMO], 1u); break; } }
    }
    nloc = mine > 0u ? mine : 1u; nx = cnt > 0u ? cnt : 1u;
}

__device__ __forceinline__ void xcd_barrier(const XcdBarrier& b) {
    asm volatile("s_waitcnt vmcnt(0)" ::: "memory");
    __syncthreads();
    if (threadIdx.x == 0) {
        unsigned* bar = b.bar;
        __builtin_amdgcn_s_waitcnt(0);
        unsigned nloc = b.st[0], nx = b.st[1];
        if (nloc == 0u) { xcd_barrier_complete(bar, b.x, nloc, nx); b.st[0] = nloc; b.st[1] = nx; }
        const unsigned old = xb_add(&bar[XB_XSUB(b.x)], 1u);
        const unsigned gen = old / nloc;
        if (old + 1u == (gen + 1u) * nloc) {
            __builtin_amdgcn_fence(__ATOMIC_RELEASE, "agent");
            asm volatile("s_waitcnt vmcnt(0)" ::: "memory");
            const unsigned og = xb_add(&bar[XB_TOP], 1u);
            const unsigned tg = og / nx;
            if (og + 1u == (tg + 1u) * nx) xb_add(&bar[XB_TOPGEN], 1u);
            else XB_SPIN(xb_ld(&bar[XB_TOPGEN]) == tg, bar);
            __builtin_amdgcn_fence(__ATOMIC_ACQUIRE, "agent");
            xb_add(&bar[XB_XGEN(b.x)], 1u);
            asm volatile("s_waitcnt vmcnt(0)" ::: "memory");
        } else {
            XB_SPIN(xb_ld(&bar[XB_XGEN(b.x)]) == gen, bar);
            __builtin_amdgcn_fence(__ATOMIC_ACQUIRE, "agent");
            asm volatile("s_waitcnt vmcnt(0)" ::: "memory");
        }
    }
    __syncthreads();
}
struct Args { const float* in[26]; float* out; unsigned char* ws; int ph_lo, ph_hi; };

__device__ __forceinline__ int src_col(int kind, int n) {
    if (kind == 1) { if (n < 1280) { const int p = n & 127, j = p >> 1, s = p & 1; return (n & ~127) + (j >> 5) * 64 + s * 32 + (j & 31); } return n; }
    if (kind == 2) { const int pn = n >> 8, bj = (n >> 7) & 1, j = n & 127; return bj * DFF + pn * 128 + j; }
    return n;
}
__device__ __forceinline__ void p0_transpose_item(const float* W, int K, int N, bf16* WT, LAS float* scr, int item, int lane, int kind) {
    const int nblk = N / 32, kb = item / nblk, nb = item % nblk, k0 = 64 * kb, n0 = 32 * nb;
    const int sc = src_col(kind, n0 + (lane & 31));
#pragma unroll 8
    for (int i = 0; i < 32; ++i) { const int kk = 2 * i + (lane >> 5); scr[kk * 33 + (lane & 31)] = W[(size_t)(k0 + kk) * N + sc]; }
    LDS_WAIT(); asm volatile("" ::: "memory");
    const int c = lane & 7;
#pragma unroll
    for (int j = 0; j < 4; ++j) { const int n = (lane >> 3) + 8 * j; const LAS float* s = scr + (8 * c) * 33 + n;
        v4u o; o.x = pk2(s[0 * 33], s[1 * 33]); o.y = pk2(s[2 * 33], s[3 * 33]); o.z = pk2(s[4 * 33], s[5 * 33]); o.w = pk2(s[6 * 33], s[7 * 33]);
        *(GAS v4u*)(WT + (size_t)(n0 + n) * K + k0 + 8 * c) = o; }
    LDS_WAIT(); asm volatile("" ::: "memory");
}
constexpr int IT_WIN = (DM / 64) * (DIN / 32), IT_WOUT = (DM / 64) * (DM / 32), IT_W1 = (DM / 64) * (2 * DFF / 32), IT_W2 = (DFF / 64) * (DM / 32), IT_LAYER = IT_WIN + IT_WOUT + IT_W1 + IT_W2;

__device__ __forceinline__ void p0_prologue(const Args& a, LAS unsigned char* lds, int tid, int lane, int wave, int G) {
    unsigned char* ws = a.ws;
    LAS float* sil = (LAS float*)(lds + 69632);
    for (int e = tid; e < 3 * 2048; e += 512) { const int cd = e >> 11, k = e & 2047; const float v = cd == 0 ? a.in[6][k] : a.in[5][(cd - 1) * 2048 + k]; sil[e] = v * sigmoidf_(v); }
    __syncthreads();
    float* modp = (float*)(ws + WS_MODP);
    for (int it = blockIdx.x; it < 384; it += G) {
        const int l = it / 96, rem = it % 96, ks = rem / 6, cb = rem % 6, col = cb * 2048 + tid * 4;
        const float* Wp = a.in[7] + ((size_t)l * 2048 + ks * 128) * 12288 + col;
        f32x4 a0 = (f32x4){0.f, 0.f, 0.f, 0.f}, a1 = a0, a2 = a0;
#pragma unroll 8
        for (int k = 0; k < 128; ++k) { const f32x4 w = *(const f32x4*)(Wp + (size_t)k * 12288); a0 += sil[ks * 128 + k] * w; a1 += sil[2048 + ks * 128 + k] * w; a2 += sil[4096 + ks * 128 + k] * w; }
        float* o = modp + ((size_t)(ks * 4 + l) * 3) * 12288 + col;
        *(f32x4*)o = a0; *(f32x4*)(o + 12288) = a1; *(f32x4*)(o + 2 * 12288) = a2;
    }
    LAS float* scr = (LAS float*)(lds + wave * 8448);
    const int gw = blockIdx.x * NWAVES + wave, NGW = G * NWAVES;
    for (int it = gw; it < DEPTH * IT_LAYER; it += NGW) {
        const int l = it / IT_LAYER; int r = it % IT_LAYER;
        if (r < IT_WIN) { p0_transpose_item(a.in[11] + (size_t)l * DM * DIN, DM, DIN, (bf16*)(ws + WS_WIN + l * SZ_WIN), scr, r, lane, 1); continue; } r -= IT_WIN;
        if (r < IT_WOUT) { p0_transpose_item(a.in[22] + (size_t)l * DM * DM, DM, DM, (bf16*)(ws + WS_WOUT + l * SZ_WOUT), scr, r, lane, 0); continue; } r -= IT_WOUT;
        if (r < IT_W1) { p0_transpose_item(a.in[23] + (size_t)l * DM * 2 * DFF, DM, 2 * DFF, (bf16*)(ws + WS_W1 + l * SZ_W1), scr, r, lane, 2); continue; } r -= IT_W1;
        p0_transpose_item(a.in[24] + (size_t)l * DFF * DM, DFF, DM, (bf16*)(ws + WS_W2 + l * SZ_W2), scr, r, lane, 0);
    }
    const int gt = blockIdx.x * 512 + tid, NGT = G * 512;
    bf16* GW = (bf16*)(ws + WS_GW);
    for (int e = gt; e < DEPTH * 2 * 2 * 512 * 128; e += NGT) { const int k = e & 127, o = (e >> 7) & 511, g = (e >> 16) & 1, d = (e >> 17) & 1, l = e >> 18, n = o >> 7, dd = o & 127;
        GW[e] = (bf16)f2bf((g ? a.in[17] : a.in[15])[((size_t)((l * 2 + d) * 4 + n) * 128 + k) * 128 + dd]); }
    bf16* PW = (bf16*)(ws + WS_PW);
    for (int e = gt; e < DEPTH * 4 * 128 * 128; e += NGT) { const int k = e & 127, dd = (e >> 7) & 127, g = (e >> 14) & 3, l = e >> 16; PW[e] = (bf16)f2bf(a.in[20][((size_t)(l * 4 + g) * 128 + k) * 128 + dd]); }
    bf16* CKB = (bf16*)(ws + WS_CKB); bf16* CVB = (bf16*)(ws + WS_CVB);
    for (int e = gt; e < 2 * 4 * 512 * 256; e += NGT) { const int col = e & 255, rest = e >> 8, kvh = col >> 7, p = col & 127, j = p >> 1, s = p & 1, nat = (j >> 5) * 64 + s * 32 + (j & 31);
        CKB[e] = (bf16)f2bf(a.in[2][(size_t)rest * 256 + kvh * 128 + nat]); CVB[e] = (bf16)f2bf(a.in[3][e]); }
    float* rope = (float*)(ws + WS_ROPE);
    for (int e = gt; e < 2048; e += NGT) { const int p = e >> 5, i = e & 31; const float inv = __builtin_amdgcn_exp2f(-(float)i * 0.41524101186092029f); const float ang = (float)p * inv;
        double rev = (double)ang * 0.15915494309189535; rev -= (double)(long long)rev; const float rf = (float)rev;
        rope[e] = __builtin_amdgcn_cosf(rf); rope[2048 + e] = __builtin_amdgcn_sinf(rf); }
}
__device__ __forceinline__ void p1_modreduce(const Args& a, int tid, int G) {
    const float* modp = (const float*)(a.ws + WS_MODP); float* modv = (float*)(a.ws + WS_MODV);
    for (int e4 = blockIdx.x * 512 + tid; e4 < 4 * 3 * 12288 / 4; e4 += G * 512) { const int e = e4 * 4, n = e % 12288, lc = e / 12288, l = lc / 3, cd = lc % 3;
        f32x4 v = *(const f32x4*)(a.in[8] + l * 12288 + n);
#pragma unroll
        for (int ks = 0; ks < 16; ++ks) v += *(const f32x4*)(modp + ((size_t)(ks * 4 + l) * 3 + cd) * 12288 + n);
        *(f32x4*)(modv + e) = v; }
}
__device__ __forceinline__ void norm_phase(const float* xc, const float* xl, const float* gn, const float* modl, int sh_idx, int sc_idx, bf16* H, int gw, int NGW, int lane) {
    const int rpw = (MTOK + NGW - 1) / NGW; int ccur = -1; f32x4 ga[8], sh[8];
    for (int m = gw * rpw; m < (gw + 1) * rpw && m < MTOK; ++m) {
        const int cond = m < NCTX ? 0 : (m < NCTX + 2048 ? 1 : 2);
        if (cond != ccur) { ccur = cond; const float* sc = modl + cond * 12288 + sc_idx * 2048; const float* sf = modl + cond * 12288 + sh_idx * 2048;
#pragma unroll
            for (int j = 0; j < 8; ++j) { const f32x4 g = *(const f32x4*)(gn + 256 * j + 4 * lane), s = *(const f32x4*)(sc + 256 * j + 4 * lane); ga[j] = g * (1.0f + s); sh[j] = *(const f32x4*)(sf + 256 * j + 4 * lane); } }
        const float* xr = m < NCTX ? xc + (size_t)m * DM : xl + (size_t)(m - NCTX) * DM;
        f32x4 v[8]; float ss = 0.f;
#pragma unroll
        for (int j = 0; j < 8; ++j) { v[j] = *(const f32x4*)(xr + 256 * j + 4 * lane); ss += (v[j].x * v[j].x + v[j].y * v[j].y) + (v[j].z * v[j].z + v[j].w * v[j].w); }
        const float rstd = 1.0f / sqrtf(wave_sum(ss) * (1.0f / DM) + 1e-6f);
        unsigned long long* o8 = (unsigned long long*)(H + (size_t)m * DM) + lane;
#pragma unroll
        for (int j = 0; j < 8; ++j) { const f32x4 y = v[j] * rstd * ga[j] + sh[j]; o8[64 * j] = (unsigned long long)pk2(y.x, y.y) | ((unsigned long long)pk2(y.z, y.w) << 32); }
    }
}
__device__ __forceinline__ void final_norm_phase(const float* x, const float* gn, float* out, int gw, int NGW, int lane) {
    f32x4 ga[8];
#pragma unroll
    for (int j = 0; j < 8; ++j) ga[j] = *(const f32x4*)(gn + 256 * j + 4 * lane);
    for (int m = gw; m < MTOK; m += NGW) {
        const float* xr = x + (size_t)m * DM; f32x4 v[8]; float ss = 0.f;
#pragma unroll
        for (int j = 0; j < 8; ++j) { v[j] = *(const f32x4*)(xr + 256 * j + 4 * lane); ss += (v[j].x * v[j].x + v[j].y * v[j].y) + (v[j].z * v[j].z + v[j].w * v[j].w); }
        const float rstd = 1.0f / sqrtf(wave_sum(ss) * (1.0f / DM) + 1e-6f);
#pragma unroll
        for (int j = 0; j < 8; ++j) *(f32x4*)(out + (size_t)m * DM + 256 * j + 4 * lane) = v[j] * rstd * ga[j];
    }
}
struct SeqInfo { int T, seq, t0, seqrow0, nch, cc, chunk0; bool lat; };
__device__ __forceinline__ SeqInfo seq_info(int chunk) {
    SeqInfo s; const int r0 = chunk * 64;
    if (r0 < NCTX) { s.T = 256; s.seq = r0 >> 8; s.t0 = r0 & 255; s.seqrow0 = s.seq * 256; s.nch = 4; s.chunk0 = s.seq * 4; s.lat = false; }
    else { const int rr = r0 - NCTX; s.T = 2048; s.seq = rr >> 11; s.t0 = rr & 2047; s.seqrow0 = NCTX + s.seq * 2048; s.nch = 32; s.chunk0 = 128 + s.seq * 32; s.lat = true; }
    s.cc = s.t0 >> 6; return s;
}
constexpr int LU_UB = 0, LU_UF = 17408, LU_A = LU_UF + 33792, LU_B = LU_A + 33792, LU_END = LU_B + 33792;
static_assert(LU_END <= RING_BYTES, "LRU unit LDS");
template <int PASS>
__device__ __forceinline__ void lru_unit(const Args& a, LAS unsigned char* lds, int l, int chunk, int nblk, int tid, int lane, int wave) {
    const SeqInfo si = seq_info(chunk); const int r0 = chunk * 64;
    const bf16* P = (const bf16*)(a.ws + WS_P); const bf16* GW = (const bf16*)(a.ws + WS_GW);
    float2* summ = (float2*)(a.ws + WS_SUMM);
    LAS float* UF = (LAS float*)(lds + LU_UF); LAS float* A_ = (LAS float*)(lds + LU_A); LAS float* B_ = (LAS float*)(lds + LU_B);
    {
        const int cg = tid & 15, tg = tid >> 4, c8 = cg * 8, cb = nblk * 128 + c8;
        float xw[5][8];
#pragma unroll
        for (int j = 0; j < 5; ++j) { const int tl = si.t0 + tg * 2 + j - 2;
            if (tl >= 0 && tl < si.T) { const bf16x8 v = *(const bf16x8*)(P + (size_t)(si.seqrow0 + tl) * DIN + 1536 + cb);
#pragma unroll
                for (int e = 0; e < 8; ++e) xw[j][e] = bf2f((unsigned short)v[e]); }
            else {
#pragma unroll
                for (int e = 0; e < 8; ++e) xw[j][e] = 0.f; } }
        float cw[4][8], cbias[8];
#pragma unroll
        for (int j = 0; j < 4; ++j) { const f32x4 w0 = *(const f32x4*)(a.in[13] + (size_t)(l * 4 + j) * 512 + cb), w1 = *(const f32x4*)(a.in[13] + (size_t)(l * 4 + j) * 512 + cb + 4);
            cw[j][0] = w0.x; cw[j][1] = w0.y; cw[j][2] = w0.z; cw[j][3] = w0.w; cw[j][4] = w1.x; cw[j][5] = w1.y; cw[j][6] = w1.z; cw[j][7] = w1.w; }
        { const f32x4 b0 = *(const f32x4*)(a.in[14] + l * 512 + cb), b1 = *(const f32x4*)(a.in[14] + l * 512 + cb + 4);
            cbias[0] = b0.x; cbias[1] = b0.y; cbias[2] = b0.z; cbias[3] = b0.w; cbias[4] = b1.x; cbias[5] = b1.y; cbias[6] = b1.z; cbias[7] = b1.w; }
#pragma unroll
        for (int q = 0; q < 2; ++q) { const int t = tg * 2 + q; float u[8];
#pragma unroll
            for (int e = 0; e < 8; ++e) u[e] = cbias[e] + cw[0][e] * xw[q][e] + cw[1][e] * xw[q + 1][e] + cw[2][e] * xw[q + 2][e] + cw[3][e] * xw[q + 3][e];
            *(LAS f32x4*)(UF + t * 132 + c8) = (f32x4){u[0], u[1], u[2], u[3]}; *(LAS f32x4*)(UF + t * 132 + c8 + 4) = (f32x4){u[4], u[5], u[6], u[7]};
            v4u w; w.x = pk2(u[0], u[1]); w.y = pk2(u[2], u[3]); w.z = pk2(u[4], u[5]); w.w = pk2(u[6], u[7]);
            *(LAS v4u*)(lds + LU_UB + t * 272 + c8 * 2) = w; }
    }
    __syncthreads();
    const int q = lane >> 4, cl = lane & 15, ch = wave * 16 + cl, chg = nblk * 128 + ch;
    const int c2 = nblk * 128 + tid;
    float y[64];
#pragma unroll
    for (int d = 0; d < 2; ++d) {
        f32x4 acc[2][4];
#pragma unroll
        for (int g = 0; g < 2; ++g)
#pragma unroll
            for (int m = 0; m < 4; ++m) acc[g][m] = (f32x4){0.f, 0.f, 0.f, 0.f};
#pragma unroll
        for (int ks = 0; ks < 4; ++ks) {
            bf16x8 bw[2];
#pragma unroll
            for (int g = 0; g < 2; ++g) bw[g] = *(const bf16x8*)(GW + ((size_t)((l * 2 + d) * 2 + g) * 512 + chg) * 128 + ks * 32 + 8 * q);
#pragma unroll
            for (int m = 0; m < 4; ++m) { const bf16x8 au = *(const LAS bf16x8*)(lds + LU_UB + (m * 16 + cl) * 272 + (ks * 32 + 8 * q) * 2);
#pragma unroll
                for (int g = 0; g < 2; ++g) acc[g][m] = __builtin_amdgcn_mfma_f32_16x16x32_bf16(au, bw[g], acc[g][m], 0, 0, 0); }
        }
        {
            const float bav = a.in[16][(l * 2 + d) * 512 + chg], bxv = a.in[18][(l * 2 + d) * 512 + chg], lamv = a.in[19][(l * 2 + d) * 512 + chg];
            const float ls8 = -8.0f * log1pf(expf(-lamv));
#pragma unroll
            for (int m = 0; m < 4; ++m)
#pragma unroll
                for (int rg = 0; rg < 4; ++rg) { const int t = m * 16 + 4 * q + rg;
                    const float r = sigmoidf_(acc[0][m][rg] + bav), ig = sigmoidf_(acc[1][m][rg] + bxv);
                    const float la = ls8 * r, av = __builtin_amdgcn_exp2f(la * 1.4426950408889634f), x2 = 2.0f * la;
                    const float om = x2 > -0.02f ? -x2 * (1.0f + 0.5f * x2 * (1.0f + x2 * 0.33333333f)) : 1.0f - av * av;
                    const float bv = __builtin_amdgcn_sqrtf(om) * ig * UF[t * 132 + ch];
                    A_[t * 132 + ch] = av; B_[t * 132 + ch] = bv; }
        }
        __syncthreads();
        if (tid < 128) {
            if (PASS == 1) {
                float Ap = 1.f, Bp = 0.f;
#pragma unroll 8
                for (int i = 0; i < 64; ++i) { const int t = d ? 63 - i : i; const float av = A_[t * 132 + tid], bv = B_[t * 132 + tid]; Bp = av * Bp + bv; Ap *= av; }
                summ[(size_t)(chunk * 2 + d) * 512 + c2] = make_float2(Ap, Bp);
            } else {
                float h = si.lat ? a.in[4][(size_t)((si.seq * 4 + l) * 2 + d) * 512 + c2] : 0.f;
                if (d == 0) { for (int j = 0; j < si.cc; ++j) { const float2 s = summ[(size_t)((si.chunk0 + j) * 2 + 0) * 512 + c2]; h = s.x * h + s.y; } }
                else { for (int j = si.nch - 1; j > si.cc; --j) { const float2 s = summ[(size_t)((si.chunk0 + j) * 2 + 1) * 512 + c2]; h = s.x * h + s.y; } }
#pragma unroll
                for (int i = 0; i < 64; ++i) { const int t = d ? 63 - i : i; h = A_[t * 132 + tid] * h + B_[t * 132 + tid]; if (d == 0) y[t] = h; else y[t] += h; }
                if (!si.lat) { if (d == 0 && si.cc == si.nch - 1) a.out[O_ST + (size_t)((si.seq * 4 + l) * 2 + 0) * 512 + c2] = h;
                               if (d == 1 && si.cc == 0) a.out[O_ST + (size_t)((si.seq * 4 + l) * 2 + 1) * 512 + c2] = h; }
            }
        }
        __syncthreads();
    }
    if (PASS == 2 && tid < 128) {
        bf16* mix = (bf16*)(a.ws + WS_MIX);
#pragma unroll
        for (int t = 0; t < 64; ++t) { const float g = bf2f(P[(size_t)(r0 + t) * DIN + 2048 + c2]); const float z = 0.7978845608028654f * (g + 0.044715f * g * g * g);
            mix[(size_t)(r0 + t) * DM + 1024 + c2] = (bf16)f2bf(y[t] * g * sigmoidf_(2.0f * z)); }
    }
}
__device__ __forceinline__ void pool_unit(const Args& a, LAS unsigned char* lds, int l, int chunk, int g, int tid, int lane, int wave) {
    const SeqInfo si = seq_info(chunk); const int r0 = chunk * 64;
    const bf16* P = (const bf16*)(a.ws + WS_P); const bf16* PW = (const bf16*)(a.ws + WS_PW); bf16* mix = (bf16*)(a.ws + WS_MIX);
    {
        const int w2 = 1 << g, cg = tid & 15, tg = tid >> 4, c8 = cg * 8, colp = 2560 + g * 128 + c8;
#pragma unroll
        for (int qq = 0; qq < 2; ++qq) { const int t = tg * 2 + qq, tl = si.t0 + t; const int lo = tl - w2 > 0 ? tl - w2 : 0, hi = tl + w2 < si.T ? tl + w2 : si.T;
            float s[8];
#pragma unroll
            for (int e = 0; e < 8; ++e) s[e] = 0.f;
            for (int r = lo; r < hi; ++r) { const bf16x8 v = *(const bf16x8*)(P + (size_t)(si.seqrow0 + r) * DIN + colp);
#pragma unroll
                for (int e = 0; e < 8; ++e) s[e] += bf2f((unsigned short)v[e]); }
            const bf16x8 sv = *(const bf16x8*)(P + (size_t)(si.seqrow0 + tl) * DIN + colp); const float inv = 1.0f / (float)(hi - lo);
            float pz[8];
#pragma unroll
            for (int e = 0; e < 8; ++e) pz[e] = s[e] * inv - bf2f((unsigned short)sv[e]);
            v4u w; w.x = pk2(pz[0], pz[1]); w.y = pk2(pz[2], pz[3]); w.z = pk2(pz[4], pz[5]); w.w = pk2(pz[6], pz[7]);
            *(LAS v4u*)(lds + LU_UB + t * 272 + c8 * 2) = w; }
    }
    __syncthreads();
    const int q = lane >> 4, cl = lane & 15, dch = wave * 16 + cl;
    f32x4 acc[4];
#pragma unroll
    for (int m = 0; m < 4; ++m) acc[m] = (f32x4){0.f, 0.f, 0.f, 0.f};
#pragma unroll
    for (int ks = 0; ks < 4; ++ks) { const bf16x8 bw = *(const bf16x8*)(PW + ((size_t)(l * 4 + g) * 128 + dch) * 128 + ks * 32 + 8 * q);
#pragma unroll
        for (int m = 0; m < 4; ++m) { const bf16x8 au = *(const LAS bf16x8*)(lds + LU_UB + (m * 16 + cl) * 272 + (ks * 32 + 8 * q) * 2); acc[m] = __builtin_amdgcn_mfma_f32_16x16x32_bf16(au, bw, acc[m], 0, 0, 0); } }
    const float sc = a.in[21][l * 512 + g * 128 + dch];
#pragma unroll
    for (int m = 0; m < 4; ++m)
#pragma unroll
        for (int rg = 0; rg < 4; ++rg) { const int t = m * 16 + 4 * q + rg; mix[(size_t)(r0 + t) * DM + 1536 + g * 128 + dch] = (bf16)f2bf(acc[m][rg] * sc); }
    __syncthreads();
}
__device__ __forceinline__ void attn_ctx_unit(const Args& a, char* lds, int l, int i) {
    const int b = i >> 3, h = i & 7, kvh = h >> 2;
    const bf16* P = (const bf16*)(a.ws + WS_P); bf16* mix = (bf16*)(a.ws + WS_MIX);
    att::Src S; S.k0 = P + (size_t)(b * 256) * DIN + 1024 + kvh * 128; S.v0 = S.k0 + 256; S.ld0 = DIN; S.n0 = 4; S.k1 = S.k0; S.v1 = S.v0; S.ld1 = DIN; S.nt = 4; S.jb_lo = 0;
    att::attn_unit<false>(P + (size_t)(b * 256) * DIN + h * 128, DIN, S, a.in[12][l * 8 + h], mix + (size_t)(b * 256) * DM + h * 128, DM, lds);
}
__device__ __forceinline__ void attn_lat_unit(const Args& a, char* lds, int l, int i) {
    const int b = i >> 6, h = (i >> 3) & 7, qb = i & 7, kvh = h >> 2, q0 = qb * 256, rowbase = NCTX + b * 2048;
    const bf16* P = (const bf16*)(a.ws + WS_P); bf16* mix = (bf16*)(a.ws + WS_MIX);
    const bf16* CKB = (const bf16*)(a.ws + WS_CKB); const bf16* CVB = (const bf16*)(a.ws + WS_CVB);
    const int jb_lo = qb == 0 ? 2 : 0, jb_hi = qb == 7 ? 6 : 8;
    att::Src S; S.k0 = CKB + (size_t)((b * 4 + l) * 512) * 256 + kvh * 128; S.v0 = CVB + (size_t)((b * 4 + l) * 512) * 256 + kvh * 128; S.ld0 = 256; S.n0 = 8;
    S.k1 = P + (size_t)(rowbase + q0 - 128 + jb_lo * 64) * DIN + 1024 + kvh * 128; S.v1 = S.k1 + 256; S.ld1 = DIN; S.nt = 8 + jb_hi - jb_lo; S.jb_lo = jb_lo;
    att::attn_unit<true>(P + (size_t)(rowbase + q0) * DIN + h * 128, DIN, S, a.in[12][l * 8 + h], mix + (size_t)(rowbase + q0) * DM + h * 128, DM, lds);
}
constexpr int N_PHASES = 2 + 8 * DEPTH + 1;
__device__ __forceinline__ int att_index(int w, int s, int G) {
    if (G == 256) { if (w < 128) return s == 0 ? w : -1; return s < 2 ? 128 + 2 * (w - 128) + s : -1; }
    const int i = w + s * G; return i < 384 ? i : -1;
}
__device__ __forceinline__ int lru_index(int w, int s, int G) {
    if (G == 256) { if (w >= 128) return s < 5 ? (w - 128) * 5 + s : -1; return s == 0 ? 640 + w : -1; }
    const int i = w + s * G; return i < 768 ? i : -1;
}
#if defined(__HIP_DEVICE_COMPILE__)
#define PHASE_ARGS const __attribute__((address_space(4))) Args* ap_ = (const __attribute__((address_space(4))) Args*)__builtin_amdgcn_kernarg_segment_ptr(); asm volatile("" : "+s"(ap_)); const Args a = *ap_;
#else
#define PHASE_ARGS const Args a = a_;
#endif
#define PHASE_LOCALS int tid = threadIdx.x; asm volatile("" : "+v"(tid)); const int lane = tid & 63, wave = __builtin_amdgcn_readfirstlane(tid >> 6); PHASE_ARGS \
    unsigned char* ws = a.ws; const int G = gridDim.x; const int gw = blockIdx.x * NWAVES + wave, NGW = G * NWAVES; (void)lane; (void)gw; (void)NGW; (void)ws;
__global__ void __launch_bounds__(NWAVES * 64, 2) fwd_kernel(Args a_) {
    extern __shared__ __attribute__((aligned(16))) unsigned char lds_raw[];
    LAS unsigned char* lds = (LAS unsigned char*)lds_raw;
    for (int u = threadIdx.x; u < (LDS_BYTES - LDSCTL_OFF) / 4; u += NWAVES * 64) ((LAS unsigned*)(lds + LDSCTL_OFF))[u] = 0u;
    __syncthreads();
#if !MK_PER_PHASE
    XcdBarrier bar = xcd_barrier_post((unsigned*)(a_.ws + WS_CTL) + CW_BAR, (volatile LAS unsigned*)(lds + MISC_OFF) + 8);
#define SEAM(k) do { if ((k) + 1 < hi) xcd_barrier(bar); } while (0)
#else
#define SEAM(k) do { } while (0)
#endif
    const int lo = a_.ph_lo, hi = a_.ph_hi;
#define IN(k) (lo <= (k) && (k) < hi)
#define XBUF ((float*)(ws + WS_X))
#define HB ((bf16*)(ws + WS_H))
#define PB ((bf16*)(ws + WS_P))
#define MIXB ((bf16*)(ws + WS_MIX))
#define ACTB ((bf16*)(ws + WS_ACT))
#define MODL ((const float*)(ws + WS_MODV) + (size_t)l * 3 * 12288)
#define ROPE ((const float*)(ws + WS_ROPE))
#define XC (l == 0 ? a.in[0] : (const float*)XBUF)
#define XL (l == 0 ? a.in[1] : (const float*)XBUF + (size_t)NCTX * DM)

#ifndef NO_PRO
    if (IN(0)) { { PHASE_LOCALS p0_prologue(a, lds, tid, lane, wave, G); } SEAM(0); }
    if (IN(1)) { { PHASE_LOCALS p1_modreduce(a, tid, G); } SEAM(1); }
#endif
    for (int l = 0; l < DEPTH; ++l) {
        const int pb = 2 + 8 * l;
#ifndef NO_NORM
        if (IN(pb + 0)) { { PHASE_LOCALS norm_phase(XC, XL, a.in[9] + l * DM, MODL, 0, 1, HB, gw, NGW, lane); } SEAM(pb + 0); }
#endif
#ifndef NO_G1
        if (IN(pb + 1)) {
            { PHASE_LOCALS
            pg8::Gemm g{HB, (const bf16*)(ws + WS_WIN + l * SZ_WIN), MTOK, DIN, DM}; pg8::StaticOrder S; S.init(MTOK, DIN, G, (int)blockIdx.x);
            pg8::EpiIn E{PB, a.out + O_CK, a.out + O_CV, ROPE, ROPE + 2048, l};
            pg8::gemm_phase<pg8::EpiIn, pg8::StaticOrder, true, true>(lds + RING_OFF, g, S, E); }
            SEAM(pb + 1);
        }
#endif
#ifndef NO_LRU1
        if (IN(pb + 2)) { { PHASE_LOCALS for (int u = blockIdx.x; u < 768; u += G) lru_unit<1>(a, lds, l, u >> 2, u & 3, tid, lane, wave); } SEAM(pb + 2); }
#endif
        if (IN(pb + 3)) {
#ifndef NO_ATT
            { PHASE_LOCALS
            for (int s = 0;; ++s) { const int i = att_index((int)blockIdx.x, s, G); if (i < 0) break; if (i < 128) attn_lat_unit(a, (char*)lds_raw, l, i); else attn_ctx_unit(a, (char*)lds_raw, l, i - 128); } }
#endif
            __syncthreads();
#ifndef NO_LRU2
            { PHASE_LOCALS
            for (int s = 0;; ++s) { const int u = lru_index((int)blockIdx.x, s, G); if (u < 0) break; lru_unit<2>(a, lds, l, u >> 2, u & 3, tid, lane, wave); } }
#endif
#ifndef NO_POOL
            { PHASE_LOCALS for (int u = blockIdx.x; u < 768; u += G) pool_unit(a, lds, l, u >> 2, u & 3, tid, lane, wave); }
#endif
            SEAM(pb + 3);
        }
#ifndef NO_G2
        if (IN(pb + 4)) {
            { PHASE_LOCALS
            pg8::Gemm g{MIXB, (const bf16*)(ws + WS_WOUT + l * SZ_WOUT), MTOK, DM, DM}; pg8::StaticOrder S; S.init(MTOK, DM, G, (int)blockIdx.x);
            pg8::EpiRes E{XC, XL, XBUF, MODL + 2 * 2048};
            pg8::gemm_phase<pg8::EpiRes, pg8::StaticOrder, true, true>(lds + RING_OFF, g, S, E); }
            SEAM(pb + 4);
        }
#endif
#ifndef NO_NORM
        if (IN(pb + 5)) { { PHASE_LOCALS norm_phase(XBUF, XBUF + (size_t)NCTX * DM, a.in[10] + l * DM, MODL, 3, 4, HB, gw, NGW, lane); } SEAM(pb + 5); }
#endif
#ifndef NO_G3
        if (IN(pb + 6)) {
            { PHASE_LOCALS
            pg8::Gemm g{HB, (const bf16*)(ws + WS_W1 + l * SZ_W1), MTOK, 2 * DFF, DM}; pg8::StaticOrder S; S.init(MTOK, 2 * DFF, G, (int)blockIdx.x);
            pg8::EpiSwiGLU E{ACTB};
            pg8::gemm_phase<pg8::EpiSwiGLU, pg8::StaticOrder, true, true>(lds + RING_OFF, g, S, E); }
            SEAM(pb + 6);
        }
#endif
#ifndef NO_G4
        if (IN(pb + 7)) {
            { PHASE_LOCALS
            pg8::Gemm g{ACTB, (const bf16*)(ws + WS_W2 + l * SZ_W2), MTOK, DM, DFF}; pg8::StaticOrder S; S.init(MTOK, DM, G, (int)blockIdx.x);
            pg8::EpiRes E{XBUF, XBUF + (size_t)NCTX * DM, XBUF, MODL + 5 * 2048};
            pg8::gemm_phase<pg8::EpiRes, pg8::StaticOrder, true, true>(lds + RING_OFF, g, S, E); }
            SEAM(pb + 7);
        }
#endif
    }
    if (IN(N_PHASES - 1)) { PHASE_LOCALS final_norm_phase(XBUF, a.in[25], a.out + O_YP, gw, NGW, lane); }
#undef IN
#undef SEAM
}

extern "C" void kernel_launch(void* const* d_in, const int* in_sizes, int n_in, void* d_out, int out_size, void* d_ws, size_t ws_size, hipStream_t stream) {
    static int grid = 0;
    if (grid == 0) {
        if (n_in != 26 || (size_t)out_size != O_END || ws_size < WS_END) { fprintf(stderr, "kernel_launch: built for 26 inputs, %zu outputs, >= %zu bytes of workspace; got n_in %d, out %d, ws %zu; nothing launched\n", (size_t)O_END, (size_t)WS_END, n_in, out_size, ws_size); grid = -1; return; }
        int dev = 0, cus = 0, per_cu = 0;
        if (hipGetDevice(&dev) != hipSuccess || hipDeviceGetAttribute(&cus, hipDeviceAttributeMultiprocessorCount, dev) != hipSuccess) { fprintf(stderr, "kernel_launch: device query failed\n"); grid = -1; return; }
        if (hipFuncSetAttribute((const void*)fwd_kernel, hipFuncAttributeMaxDynamicSharedMemorySize, LDS_BYTES) != hipSuccess) { fprintf(stderr, "kernel_launch: hipFuncSetAttribute failed\n"); grid = -1; return; }
        if (hipOccupancyMaxActiveBlocksPerMultiprocessor(&per_cu, (const void*)fwd_kernel, NWAVES * 64, LDS_BYTES) != hipSuccess || per_cu < 1)
            fprintf(stderr, "kernel_launch: note: occupancy query reports %d workgroups per CU\n", per_cu);
        (void)hipGetLastError();
        grid = cus;
    }
    if (grid < 0) return;
    if (hipMemsetAsync((char*)d_ws + WS_CTL, 0, CTL_ZERO_BYTES, stream) != hipSuccess) { fprintf(stderr, "kernel_launch: memset failed\n"); return; }
    Args a{};
    for (int i = 0; i < 26; ++i) a.in[i] = (const float*)d_in[i];
    a.out = (float*)d_out; a.ws = (unsigned char*)d_ws;
#if MK_PER_PHASE
    for (int p = 0; p < N_PHASES; ++p) { a.ph_lo = p; a.ph_hi = p + 1; hipLaunchKernelGGL(fwd_kernel, dim3(grid), dim3(NWAVES * 64), LDS_BYTES, stream, a); }
#else
    a.ph_lo = 0; a.ph_hi = N_PHASES; hipLaunchKernelGGL(fwd_kernel, dim3(grid), dim3(NWAVES * 64), LDS_BYTES, stream, a);
#endif
    const hipError_t le = hipPeekAtLastError();
    if (le != hipSuccess) fprintf(stderr, "kernel_launch: launch failed: %s\n", hipGetErrorName(le));
}
```

```cpp
#include <hip/hip_runtime.h>
#include <cstdio>
#include <cstdint>
namespace pg8 {
#define PG8_LAS __attribute__((address_space(3)))
typedef unsigned short bf16_t;
typedef short bf16x8 __attribute__((ext_vector_type(8)));
typedef float f32x4 __attribute__((ext_vector_type(4)));
typedef unsigned u32x4 __attribute__((ext_vector_type(4)));
constexpr int BM = 256, BK = 64, HALF = 128, HTB = HALF * BK * 2  , STAGE_BYTES = 8 * HTB, NXCD = 8, WGM = 8;

__host__ __device__ __forceinline__ int lds_byte(int r, int c) { const int st = (r >> 4) * 2 + (c >> 5), rr = r & 15, cc = c & 31, ob = rr * 64 + cc * 2; return st * 1024 + (ob ^ (((ob >> 9) & 1) << 5)); }
__host__ __device__ __forceinline__ void stage_rc(int b, int& R, int& C) { const int st = b / 1024, sb = b % 1024, swz = sb ^ (((sb >> 9) & 1) << 5); R = (st >> 1) * 16 + swz / 64; C = (st & 1) * 32 + (swz % 64) / 2; }
__host__ __device__ __forceinline__ int perm32(int rho) { const int n = rho >> 4, i = rho & 15; return 8 * (i >> 2) + 4 * n + (i & 3); }

struct Unit { int pm, pn; };
struct Gemm { const bf16_t* A; const bf16_t* Bt; int M, N, K; };

struct StaticOrder {
    int nM, nN, nwg, G, c;
    __host__ __device__ void init(int M, int N, int G_, int c_) { nM = M / BM; nN = N / BM; nwg = nM * nN; G = G_; c = c_; }
    __host__ __device__ bool next(int i, Unit& u) const {
        const long L = (long)i * G + c; if (L >= nwg) return false;
        int wgid = (int)L; { const int q = nwg / NXCD, r = nwg % NXCD, xcd = wgid % NXCD, off = wgid / NXCD; wgid = (xcd < r ? xcd * (q + 1) : r * (q + 1) + (xcd - r) * q) + off; }
        const int nig = WGM * nN, gid = wgid / nig, fm = gid * WGM, gsz = (nM - fm) < WGM ? (nM - fm) : WGM;
        u.pm = fm + ((wgid % nig) % gsz); u.pn = (wgid % nig) / gsz; return true;
    }
    __device__ __forceinline__ void a_ready(const Unit&) const {}
    __device__ __forceinline__ void done(const Unit&) const {}
};
__device__ __forceinline__ unsigned cvt_pk_bf16(float lo, float hi) { unsigned r; asm volatile("v_cvt_pk_bf16_f32 %0, %1, %2" : "=v"(r) : "v"(lo), "v"(hi)); return r; }
typedef float f32x2 __attribute__((ext_vector_type(2)));
struct EpiIn {
    static constexpr bool PERM = true, AFTER_DRAIN = false;
    bf16_t* P; float* outk; float* outv; const float* rcs; const float* rsn; int layer;
    __device__ __forceinline__ void operator()(const f32x4 (&acc)[2][2][4][2], const Unit& u, int wr, int wc, int fr, int fq) const {
        const bool lat = u.pm >= 32; const bool rope = lat && (u.pn <= 4); const bool kout = (!lat) && (u.pn == 4), vout = (!lat) && (u.pn == 5);
        const int i0 = (wc & 1) * 16 + 4 * fq;
#pragma unroll
        for (int ai = 0; ai < 2; ++ai)
#pragma unroll
            for (int m = 0; m < 4; ++m) {
                const int row = u.pm * BM + ai * HALF + wr * 64 + m * 16 + fr;
                f32x4 cs4 = (f32x4){1.f, 1.f, 1.f, 1.f}, sn4 = (f32x4){0.f, 0.f, 0.f, 0.f};
                if (rope) { const int t = (row - 8192) & 2047; const int p = (wc >> 1) ? (t & 63) : (t >> 6); cs4 = *(const f32x4*)(rcs + p * 32 + i0); sn4 = *(const f32x4*)(rsn + p * 32 + i0); }
#pragma unroll
                for (int bj = 0; bj < 2; ++bj) {
                    f32x4 v0 = acc[ai][bj][m][0], v1 = acc[ai][bj][m][1];
                    if (kout) { float* d = outk + ((size_t)(((row >> 8) * 4 + layer) * 256 + (row & 255)) * 256 + bj * 128 + (wc >> 1) * 64 + (wc & 1) * 16 + 4 * fq);
                        *(f32x4*)d = (f32x4){v0[0], v0[2], v1[0], v1[2]}; *(f32x4*)(d + 32) = (f32x4){v0[1], v0[3], v1[1], v1[3]}; }
                    if (vout) { float* d = outv + ((size_t)(((row >> 8) * 4 + layer) * 256 + (row & 255)) * 256 + bj * 128 + wc * 32 + 8 * fq); *(f32x4*)d = v0; *(f32x4*)(d + 4) = v1; }
                    if (rope) {
                        const f32x4 a0 = v0, a1 = v1;
                        v0[0] = a0[0] * cs4[0] - a0[1] * sn4[0]; v0[1] = a0[1] * cs4[0] + a0[0] * sn4[0];
                        v0[2] = a0[2] * cs4[1] - a0[3] * sn4[1]; v0[3] = a0[3] * cs4[1] + a0[2] * sn4[1];
                        v1[0] = a1[0] * cs4[2] - a1[1] * sn4[2]; v1[1] = a1[1] * cs4[2] + a1[0] * sn4[2];
                        v1[2] = a1[2] * cs4[3] - a1[3] * sn4[3]; v1[3] = a1[3] * cs4[3] + a1[2] * sn4[3];
                    }
                    u32x4 w; w.x = cvt_pk_bf16(v0[0], v0[1]); w.y = cvt_pk_bf16(v0[2], v0[3]); w.z = cvt_pk_bf16(v1[0], v1[1]); w.w = cvt_pk_bf16(v1[2], v1[3]);
                    *(u32x4*)(P + (size_t)row * 3072 + u.pn * BM + bj * HALF + wc * 32 + 8 * fq) = w;
                }
            }
    }
};
struct EpiRes {
    static constexpr bool PERM = false, AFTER_DRAIN = false;
    const float* bctx; const float* blat; float* out; const float* gate;
    __device__ __forceinline__ void operator()(const f32x4 (&acc)[2][2][4][2], const Unit& u, int wr, int wc, int fr, int fq) const {
        const int cond = u.pm < 32 ? 0 : (u.pm < 40 ? 1 : 2);
        const float* g = gate + cond * 12288; const float* bs = u.pm < 32 ? bctx : blat - (size_t)8192 * 2048;
        const int col0 = u.pn * BM + wc * 32 + 4 * fq;
        f32x4 gv[2][2];
#pragma unroll
        for (int bj = 0; bj < 2; ++bj)
#pragma unroll
            for (int n = 0; n < 2; ++n) gv[bj][n] = *(const f32x4*)(g + col0 + bj * HALF + n * 16);
#pragma unroll
        for (int ai = 0; ai < 2; ++ai)
#pragma unroll
            for (int m = 0; m < 4; ++m) { const size_t off = (size_t)(u.pm * BM + ai * HALF + wr * 64 + m * 16 + fr) * 2048 + col0;
#pragma unroll
                for (int bj = 0; bj < 2; ++bj)
#pragma unroll
                    for (int n = 0; n < 2; ++n) { const f32x4 b = *(const f32x4*)(bs + off + bj * HALF + n * 16); *(f32x4*)(out + off + bj * HALF + n * 16) = b + gv[bj][n] * acc[ai][bj][m][n]; }
            }
    }
};
struct EpiSwiGLU {
    static constexpr bool PERM = true, AFTER_DRAIN = false;
    bf16_t* act;
    __device__ __forceinline__ float sl(float g, float u) const { return g * u * __builtin_amdgcn_rcpf(1.0f + __builtin_amdgcn_exp2f(-1.4426950408889634f * g)); }
    __device__ __forceinline__ void operator()(const f32x4 (&acc)[2][2][4][2], const Unit& u, int wr, int wc, int fr, int fq) const {
#pragma unroll
        for (int ai = 0; ai < 2; ++ai)
#pragma unroll
            for (int m = 0; m < 4; ++m) { const int row = u.pm * BM + ai * HALF + wr * 64 + m * 16 + fr;
                const f32x4 g0 = acc[ai][0][m][0], g1 = acc[ai][0][m][1], u0 = acc[ai][1][m][0], u1 = acc[ai][1][m][1];
                u32x4 w; w.x = cvt_pk_bf16(sl(g0[0], u0[0]), sl(g0[1], u0[1])); w.y = cvt_pk_bf16(sl(g0[2], u0[2]), sl(g0[3], u0[3]));
                w.z = cvt_pk_bf16(sl(g1[0], u1[0]), sl(g1[1], u1[1])); w.w = cvt_pk_bf16(sl(g1[2], u1[2]), sl(g1[3], u1[3]));
                *(u32x4*)(act + (size_t)row * 5632 + u.pn * HALF + wc * 32 + 8 * fq) = w; }
    }
};
template <class Epi, class Sched, bool ALIGN_EPI = false, bool SP2 = false>
__device__ __forceinline__ void gemm_phase(PG8_LAS unsigned char* lds, const Gemm g, const Sched& S, const Epi& E) {
    int tid_ = threadIdx.x; asm volatile("" : "+v"(tid_));
    const int tid = tid_, wid = __builtin_amdgcn_readfirstlane(tid >> 6), lane = tid & 63, wr = wid >> 2, wc = wid & 3, fr = lane & 15, fq = lane >> 4;
    const int K = g.K, nt = K / BK;
    unsigned voffA[2], voffB[2];
#pragma unroll
    for (int i = 0; i < 2; ++i) { int R, C; stage_rc(tid * 16 + i * 8192, R, C); const int Rb = Epi::PERM ? ((R & ~31) + perm32(R & 31)) : R;
        voffA[i] = (unsigned)(R * K + C) * 2u; voffB[i] = (unsigned)(Rb * K + C) * 2u; }
    const size_t kstep = (size_t)(BK * 2);
    const size_t hstep = (size_t)HALF * K * 2;
    const size_t tstep = 2 * hstep;
    const unsigned ldsw = (unsigned)wid * 1024u;
    const int aoff = lds_byte(wr * 64 + fr, fq * 8), boff = lds_byte(wc * 32 + fr, fq * 8);
#define PG8_SA(b, h) (((b) * 2 + (h)) * HTB)
#define PG8_SB(b, h) ((4 + (b) * 2 + (h)) * HTB)
#define PG8_STAGE(bufoff, gbase, voff) do { _Pragma("unroll") for (int _i = 0; _i < 2; ++_i) \
        __builtin_amdgcn_global_load_lds((const unsigned*)((const char*)(gbase) + (voff)[_i]), (PG8_LAS unsigned*)(lds + (bufoff) + ldsw + _i * 8192), 16, 0, 0); } while (0)
#define PG8_LDA(dst, b, h) do { _Pragma("unroll") for (int m = 0; m < 4; ++m) _Pragma("unroll") for (int k = 0; k < 2; ++k) dst[m][k] = *(const PG8_LAS bf16x8*)(lds + PG8_SA(b, h) + aoff + m * 2048 + k * 1024); } while (0)
#define PG8_LDB(dst, b, h) do { _Pragma("unroll") for (int n = 0; n < 2; ++n) _Pragma("unroll") for (int k = 0; k < 2; ++k) dst[n][k] = *(const PG8_LAS bf16x8*)(lds + PG8_SB(b, h) + boff + n * 2048 + k * 1024); } while (0)
#define PG8_MMA(ai, bj, At, Bt) do { __builtin_amdgcn_s_setprio(1); _Pragma("unroll") for (int m = 0; m < 4; ++m) _Pragma("unroll") for (int n = 0; n < 2; ++n) _Pragma("unroll") for (int k = 0; k < 2; ++k) \
        acc[ai][bj][m][n] = __builtin_amdgcn_mfma_f32_16x16x32_bf16(Bt[n][k], At[m][k], acc[ai][bj][m][n], 0, 0, 0); __builtin_amdgcn_s_setprio(0); } while (0)
#define PG8_WAIT_V(n) asm volatile("s_waitcnt vmcnt(" #n ")" ::: "memory")
#define PG8_WAIT_L(n) asm volatile("s_waitcnt lgkmcnt(" #n ")" ::: "memory")
#define PG8_BAR __builtin_amdgcn_s_barrier()
#define PG8_SCHED __builtin_amdgcn_sched_barrier(0)
    Unit cur, nxt; int ui = 0;
    if (!S.next(0, cur)) return;
    f32x4 acc[2][2][4][2];
#pragma unroll
    for (int a = 0; a < 2; ++a)
#pragma unroll
        for (int b = 0; b < 2; ++b)
#pragma unroll
            for (int m = 0; m < 4; ++m)
#pragma unroll
                for (int n = 0; n < 2; ++n) acc[a][b][m][n] = (f32x4){0.f, 0.f, 0.f, 0.f};
    bf16x8 At[4][2], B0[2][2], B1[2][2];
    const char* cA = (const char*)g.A + (size_t)cur.pm * tstep; const char* cB = (const char*)g.Bt + (size_t)cur.pn * tstep;
    S.a_ready(cur);
    if constexpr (SP2) {
        PG8_STAGE(PG8_SB(0, 0), cB, voffB); PG8_STAGE(PG8_SB(0, 1), cB + hstep, voffB); PG8_STAGE(PG8_SA(0, 0), cA, voffA); PG8_STAGE(PG8_SA(0, 1), cA + hstep, voffA);
        if (wr == 1) PG8_BAR;
        PG8_WAIT_V(2); PG8_BAR;
        PG8_STAGE(PG8_SB(1, 0), cB + kstep, voffB); PG8_STAGE(PG8_SA(1, 0), cA + kstep, voffA); PG8_STAGE(PG8_SB(1, 1), cB + hstep + kstep, voffB);
        PG8_WAIT_V(6); PG8_BAR;
    } else {
        PG8_STAGE(PG8_SB(0, 0), cB, voffB); PG8_STAGE(PG8_SA(0, 0), cA, voffA); PG8_STAGE(PG8_SB(0, 1), cB + hstep, voffB); PG8_STAGE(PG8_SA(0, 1), cA + hstep, voffA);
        if (wr == 1) PG8_BAR;
        PG8_WAIT_V(4); PG8_BAR;
        PG8_STAGE(PG8_SB(1, 0), cB + kstep, voffB); PG8_STAGE(PG8_SA(1, 0), cA + kstep, voffA); PG8_STAGE(PG8_SB(1, 1), cB + hstep + kstep, voffB);
        PG8_WAIT_V(6); PG8_BAR;
    }
    for (;;) {
        const bool has_next = S.next(ui + 1, nxt);
        const char* nA = has_next ? (const char*)g.A + (size_t)nxt.pm * tstep : cA; const char* nB = has_next ? (const char*)g.Bt + (size_t)nxt.pn * tstep : cB;
        for (int t = 0; t < nt; t += 2) {
            const bool last = (t == nt - 2);
            const char* a1 = cA + (size_t)(t + 1) * kstep;
            const char* a2 = last ? nA : cA + (size_t)(t + 2) * kstep; const char* b2 = last ? nB : cB + (size_t)(t + 2) * kstep;
            const char* a3 = a2 + kstep; const char* b3 = b2 + kstep;
            if (last && has_next) S.a_ready(nxt);
            if constexpr (SP2) {
            PG8_LDB(B0, 0, 0); PG8_LDB(B1, 0, 1); PG8_SCHED; PG8_LDA(At, 0, 0); PG8_STAGE(PG8_SA(1, 1), a1 + hstep, voffA);
            PG8_WAIT_V(8); PG8_WAIT_L(0); PG8_BAR; PG8_MMA(0, 0, At, B0); PG8_MMA(0, 1, At, B1); PG8_BAR; PG8_SCHED;
            PG8_LDA(At, 0, 1); PG8_STAGE(PG8_SB(0, 0), b2, voffB); PG8_STAGE(PG8_SB(0, 1), b2 + hstep, voffB); PG8_STAGE(PG8_SA(0, 0), a2, voffA);
            PG8_WAIT_V(8); PG8_WAIT_L(0); PG8_BAR; PG8_MMA(1, 0, At, B0); PG8_MMA(1, 1, At, B1); PG8_BAR; PG8_SCHED;
            PG8_LDB(B0, 1, 0); PG8_LDB(B1, 1, 1); PG8_SCHED; PG8_LDA(At, 1, 0); PG8_STAGE(PG8_SA(0, 1), a2 + hstep, voffA);
            PG8_WAIT_V(8); PG8_WAIT_L(0); PG8_BAR; PG8_MMA(0, 0, At, B0); PG8_MMA(0, 1, At, B1); PG8_BAR; PG8_SCHED;
            PG8_LDA(At, 1, 1); PG8_STAGE(PG8_SB(1, 0), b3, voffB); PG8_STAGE(PG8_SB(1, 1), b3 + hstep, voffB); PG8_STAGE(PG8_SA(1, 0), a3, voffA);
            PG8_WAIT_V(8); PG8_WAIT_L(0); PG8_BAR; PG8_MMA(1, 0, At, B0); PG8_MMA(1, 1, At, B1); PG8_BAR; PG8_SCHED;
            } else {
            PG8_LDB(B0, 0, 0); PG8_SCHED; PG8_LDA(At, 0, 0); PG8_STAGE(PG8_SA(1, 1), a1 + hstep, voffA);
            PG8_WAIT_L(8); PG8_BAR; PG8_WAIT_L(0); PG8_MMA(0, 0, At, B0); PG8_BAR; PG8_SCHED;
            PG8_LDB(B1, 0, 1); PG8_STAGE(PG8_SB(0, 0), b2, voffB);
            PG8_BAR; PG8_WAIT_L(0); PG8_MMA(0, 1, At, B1); PG8_BAR;
            PG8_LDA(At, 0, 1); PG8_STAGE(PG8_SA(0, 0), a2, voffA);
            PG8_BAR; PG8_WAIT_L(0); PG8_MMA(1, 0, At, B0); PG8_BAR; PG8_SCHED;
            PG8_STAGE(PG8_SB(0, 1), b2 + hstep, voffB);
            PG8_WAIT_V(6); PG8_BAR; PG8_MMA(1, 1, At, B1); PG8_BAR;
            PG8_LDB(B0, 1, 0); PG8_SCHED; PG8_LDA(At, 1, 0); PG8_STAGE(PG8_SA(0, 1), a2 + hstep, voffA);
            PG8_WAIT_L(8); PG8_BAR; PG8_WAIT_L(0); PG8_MMA(0, 0, At, B0); PG8_BAR; PG8_SCHED;
            PG8_LDB(B1, 1, 1); PG8_STAGE(PG8_SB(1, 0), b3, voffB);
            PG8_BAR; PG8_WAIT_L(0); PG8_MMA(0, 1, At, B1); PG8_BAR;
            PG8_LDA(At, 1, 1); PG8_STAGE(PG8_SA(1, 0), a3, voffA);
            PG8_BAR; PG8_WAIT_L(0); PG8_MMA(1, 0, At, B0); PG8_BAR; PG8_SCHED;
            PG8_STAGE(PG8_SB(1, 1), b3 + hstep, voffB);
            PG8_WAIT_V(6); PG8_BAR; PG8_MMA(1, 1, At, B1); PG8_BAR;
            }
        }
        if constexpr (ALIGN_EPI) { if (wr == 0) PG8_BAR; }
        if constexpr (!Epi::AFTER_DRAIN) { E(acc, cur, wr, wc, fr, fq); S.done(cur); }
        if (!has_next) break;
#pragma unroll
        for (int a = 0; a < 2; ++a)
#pragma unroll
            for (int b = 0; b < 2; ++b)
#pragma unroll
                for (int m = 0; m < 4; ++m)
#pragma unroll
                    for (int n = 0; n < 2; ++n) acc[a][b][m][n] = (f32x4){0.f, 0.f, 0.f, 0.f};
        cur = nxt; cA = nA; cB = nB; ++ui;
        if constexpr (ALIGN_EPI) { if (wr == 1) PG8_BAR; }
    }
    PG8_WAIT_V(0);
    if constexpr (!ALIGN_EPI) { if (wr == 0) PG8_BAR; }
    PG8_BAR;
    if constexpr (Epi::AFTER_DRAIN) { E.fused(acc, cur, wr, wc, fr, fq, lds, wid, lane); S.done(cur); }
#undef PG8_SA
#undef PG8_SB
#undef PG8_STAGE
#undef PG8_LDA
#undef PG8_LDB
#undef PG8_MMA
#undef PG8_WAIT_V
#undef PG8_WAIT_L
#undef PG8_BAR
#undef PG8_SCHED
}
}
namespace att {
typedef unsigned short bf16;
using bf16x8 = __attribute__((ext_vector_type(8))) short;
using s16x4  = __attribute__((ext_vector_type(4))) short;
using f32x16 = __attribute__((ext_vector_type(16))) float;
using u32x4  = __attribute__((ext_vector_type(4))) unsigned;
constexpr int   D = 128, NW = 8, QBLK = 32, KVBLK = 64;
constexpr float SCALE = 0.088388347648318440f;
constexpr float THR = 8.f;
#ifndef ATT_SDEPTH
#define ATT_SDEPTH 1
#endif
constexpr int SDEPTH = ATT_SDEPTH;
constexpr size_t SHM_V = KVBLK * D * 2, SHM_K = KVBLK * D * 2, SHM_ATTN = 2 * SHM_V + 2 * SHM_K + NW * 64 * 4;
#define KSWZ(row, colB) ((row) * 256 + ((colB) ^ (((row) & 7) << 4)))
#define SBAR() __builtin_amdgcn_sched_barrier(0)
__device__ __forceinline__ int crow(int r, int hi) { return (r & 3) + 8 * (r >> 2) + 4 * hi; }
__device__ __forceinline__ unsigned cvtpk(float lo, float hi) { unsigned r; asm volatile("v_cvt_pk_bf16_f32 %0, %1, %2" : "=v"(r) : "v"(lo), "v"(hi)); return r; }
__device__ __forceinline__ bf16x8 ld8(const bf16* p) { return *reinterpret_cast<const bf16x8*>(p); }

__device__ __forceinline__ void partialSM(f32x16& p0, f32x16& p1, float& m_reg, float& mn, float& alpha) {
  constexpr float C = SCALE * 1.4426950408889634f;
  float pmax = p0[0];
#pragma unroll
  for (int r = 1; r < 16; ++r) pmax = fmaxf(pmax, p0[r]);
#pragma unroll
  for (int r = 0; r < 16; ++r) pmax = fmaxf(pmax, p1[r]);
  { auto rr = __builtin_amdgcn_permlane32_swap(__float_as_uint(pmax), __float_as_uint(pmax), false, false);
    pmax = fmaxf(__uint_as_float(rr[0]), __uint_as_float(rr[1])); }
  if (__builtin_expect(__all(pmax - m_reg <= THR / SCALE), 1)) { mn = m_reg; alpha = 1.f; }
  else { mn = fmaxf(m_reg, pmax); alpha = __builtin_amdgcn_exp2f((m_reg - mn) * C); m_reg = mn; }
  float mnC = -mn * C;
#pragma unroll
  for (int r = 0; r < 16; ++r) p0[r] = fmaf(p0[r], C, mnC);
#pragma unroll
  for (int r = 0; r < 16; ++r) p1[r] = fmaf(p1[r], C, mnC);
#pragma unroll
  for (int r = 0; r < 16; ++r) p0[r] = __builtin_amdgcn_exp2f(p0[r]);
}
__device__ __forceinline__ void finishSM(f32x16& p0, f32x16& p1, float alpha, float& l_reg, bf16x8& pa0, bf16x8& pa1, bf16x8& pa2, bf16x8& pa3) {
#pragma unroll
  for (int r = 0; r < 16; ++r) p1[r] = __builtin_amdgcn_exp2f(p1[r]);
  float ps = 0;
#pragma unroll
  for (int r = 0; r < 16; ++r) ps += p0[r];
#pragma unroll
  for (int r = 0; r < 16; ++r) ps += p1[r];
  { auto rr = __builtin_amdgcn_permlane32_swap(__float_as_uint(ps), __float_as_uint(ps), false, false);
    ps = __uint_as_float(rr[0]) + __uint_as_float(rr[1]); }
  l_reg = l_reg * alpha + ps;
#define PK4(P, BASE, OUT) do { unsigned a0 = cvtpk(P[BASE + 0], P[BASE + 1]), a1 = cvtpk(P[BASE + 2], P[BASE + 3]);   \
    unsigned b0 = cvtpk(P[BASE + 4], P[BASE + 5]), b1 = cvtpk(P[BASE + 6], P[BASE + 7]);                              \
    auto r0 = __builtin_amdgcn_permlane32_swap(a0, b0, false, false); auto r1 = __builtin_amdgcn_permlane32_swap(a1, b1, false, false); \
    u32x4 w = {r0[0], r1[0], r0[1], r1[1]}; OUT = *reinterpret_cast<bf16x8*>(&w); } while (0)
  PK4(p0, 0, pa0); PK4(p0, 8, pa1); PK4(p1, 0, pa2); PK4(p1, 8, pa3);
#undef PK4
}
__device__ __forceinline__ void qkt(f32x16& p0, f32x16& p1, const bf16* Ks, const bf16x8* qr, int r32, int hi) {
  p0 = f32x16{}; p1 = f32x16{};
#pragma unroll
  for (int d0 = 0; d0 < 8; ++d0) { int cb = (d0 * 16 + hi * 8) * 2;
    bf16x8 b0 = *reinterpret_cast<const bf16x8*>((const char*)Ks + KSWZ(r32, cb));
    bf16x8 b1 = *reinterpret_cast<const bf16x8*>((const char*)Ks + KSWZ(32 + r32, cb));
    p0 = __builtin_amdgcn_mfma_f32_32x32x16_bf16(b0, qr[d0], p0, 0, 0, 0);
    p1 = __builtin_amdgcn_mfma_f32_32x32x16_bf16(b1, qr[d0], p1, 0, 0, 0); }
}
__device__ __forceinline__ void band_mask(f32x16& p0, f32x16& p1, int base, int hi) {
#pragma unroll
  for (int r = 0; r < 16; ++r) { const int kv = crow(r, hi); if ((unsigned)(base - kv) > 256u) p0[r] = -1e30f; if ((unsigned)(base - kv - 32) > 256u) p1[r] = -1e30f; }
}
__device__ __forceinline__ int v_st(int k, int c) { const int kk = (k & ~0xC) | ((k & 4) << 1) | ((k & 8) >> 1); return ((kk >> 3) * 4 + (c >> 5)) * 512 + ((kk & 7) * 32 + (c & 31)) * 2; }
__device__ __forceinline__ int v_rd_base(int lane) { return ((lane & 3) << 3) | (((lane >> 2) & 3) << 6) | (((lane >> 4) & 1) << 5) | (((lane >> 5) & 1) << 8); }
constexpr int v_rd_off(int d0, int ks, int half) { return d0 * 512 + ks * 4096 + half * 2048; }
template <int OFF> __device__ __forceinline__ s16x4 tr_read(int vb) {
  s16x4 r; asm volatile("ds_read_b64_tr_b16 %0, %1 offset:%2" : "=&v"(r) : "v"(vb), "i"(OFF) : "memory"); return r;
}
template <int D0> __device__ __forceinline__ void pv_one(f32x16& od, int vb, bf16x8 pa0, bf16x8 pa1, bf16x8 pa2, bf16x8 pa3) {
  const s16x4 l0 = tr_read<v_rd_off(D0, 0, 0)>(vb), h0 = tr_read<v_rd_off(D0, 0, 1)>(vb), l1 = tr_read<v_rd_off(D0, 1, 0)>(vb), h1 = tr_read<v_rd_off(D0, 1, 1)>(vb);
  const s16x4 l2 = tr_read<v_rd_off(D0, 2, 0)>(vb), h2 = tr_read<v_rd_off(D0, 2, 1)>(vb), l3 = tr_read<v_rd_off(D0, 3, 0)>(vb), h3 = tr_read<v_rd_off(D0, 3, 1)>(vb);
  asm volatile("s_waitcnt lgkmcnt(0)" ::: "memory"); SBAR();
#define PK(L, H) (bf16x8){L[0], L[1], L[2], L[3], H[0], H[1], H[2], H[3]}
  od = __builtin_amdgcn_mfma_f32_32x32x16_bf16(pa0, PK(l0, h0), od, 0, 0, 0);
  od = __builtin_amdgcn_mfma_f32_32x32x16_bf16(pa1, PK(l1, h1), od, 0, 0, 0);
  od = __builtin_amdgcn_mfma_f32_32x32x16_bf16(pa2, PK(l2, h2), od, 0, 0, 0);
  od = __builtin_amdgcn_mfma_f32_32x32x16_bf16(pa3, PK(l3, h3), od, 0, 0, 0);
#undef PK
}
__device__ __forceinline__ void pv_d0(f32x16* o, int vb, bf16x8 pa0, bf16x8 pa1, bf16x8 pa2, bf16x8 pa3) {
  pv_one<0>(o[0], vb, pa0, pa1, pa2, pa3); pv_one<1>(o[1], vb, pa0, pa1, pa2, pa3); pv_one<2>(o[2], vb, pa0, pa1, pa2, pa3); pv_one<3>(o[3], vb, pa0, pa1, pa2, pa3);
}
struct Src { const bf16* k0; const bf16* v0; int ld0; int n0; const bf16* k1; const bf16* v1; int ld1; int nt; int jb_lo; };

template <bool MASKED>
__device__ __forceinline__ void attn_unit(const bf16* __restrict__ Qb, int ldq, const Src S, float sinkv, bf16* __restrict__ Ob, int ldo, char* lds) {
  int tid_ = threadIdx.x; asm volatile("" : "+v"(tid_));
  const int tid = tid_, wid = tid >> 6, lane = tid & 63, r32 = lane & 31, hi = lane >> 5;
  bf16* V_lds = (bf16*)lds; bf16* K_lds = (bf16*)(lds + 2 * SHM_V);
  float* ws = (float*)(lds + 2 * SHM_V + 2 * SHM_K) + wid * 64; float* li_l = ws; float* al_l = ws + 32;
  float m_reg = -1e30f, l_reg = 0; f32x16 o[4] = {}; bf16x8 qr[8];
  const bf16* Qw = Qb + (long)(wid * QBLK + r32) * ldq + hi * 8;
#pragma unroll
  for (int d0 = 0; d0 < 8; ++d0) qr[d0] = ld8(Qw + d0 * 16);
  const int sr = tid >> 4, sc = (tid & 15) * 8, vst0 = v_st(sr, sc), vst1 = v_st(32 + sr, sc);
  const int vb0 = (int)(uintptr_t)V_lds + v_rd_base(lane);
  const int mbase = wid * QBLK + r32 + 256;
  const unsigned voff0 = (unsigned)(sr * S.ld0 + sc), voff1 = (unsigned)(sr * S.ld1 + sc);
  struct { bf16x8 vs0, vs1, ks0, ks1; } sr_[SDEPTH];
#define SLOAD(i, j) do { const int j_ = (j); const bool s0_ = j_ < S.n0; const int ld_ = s0_ ? S.ld0 : S.ld1; const long ro_ = (long)(s0_ ? j_ : j_ - S.n0) * KVBLK * ld_; \
    const bf16* kp_ = (s0_ ? S.k0 : S.k1) + ro_; const bf16* vp_ = (s0_ ? S.v0 : S.v1) + ro_; const bf16* kq_ = kp_ + 32l * ld_; const bf16* vq_ = vp_ + 32l * ld_; const unsigned vo_ = s0_ ? voff0 : voff1; \
    sr_[i].vs0 = ld8(vp_ + vo_); sr_[i].vs1 = ld8(vq_ + vo_); sr_[i].ks0 = ld8(kp_ + vo_); sr_[i].ks1 = ld8(kq_ + vo_); } while (0)
#define SWRITE(b, i) do { *(bf16x8*)((char*)V_lds + (b) * SHM_V + vst0) = sr_[i].vs0;          \
    *(bf16x8*)((char*)V_lds + (b) * SHM_V + vst1) = sr_[i].vs1; int kc = sc * 2;               \
    *(bf16x8*)((char*)K_lds + (b) * SHM_K + KSWZ(sr, kc)) = sr_[i].ks0;                       \
    *(bf16x8*)((char*)K_lds + (b) * SHM_K + KSWZ(32 + sr, kc)) = sr_[i].ks1; } while (0)
#define SWAIT() do { if constexpr (SDEPTH == 2) asm volatile("s_waitcnt vmcnt(4)" ::: "memory"); else asm volatile("s_waitcnt vmcnt(0)" ::: "memory"); } while (0)
#define RESC(a) do { if (__any((a) < 1.f)) { if (hi == 0) al_l[r32] = (a); asm volatile("s_waitcnt lgkmcnt(0)" ::: "memory"); \
    _Pragma("unroll") for (int d = 0; d < 4; ++d) _Pragma("unroll") for (int r = 0; r < 16; ++r) o[d][r] *= al_l[crow(r, hi)]; } } while (0)
#define MASK(P0, P1, j) do { if (MASKED) { const int j_ = (j); if (j_ >= S.n0) band_mask(P0, P1, mbase - 64 * (S.jb_lo + j_ - S.n0), hi); } } while (0)
  f32x16 pA0, pA1, pB0, pB1; float mnA, mnB, alA, alB; bf16x8 pa0, pa1, pa2, pa3; const int NT = S.nt;
  constexpr int SE = 0, SO = SDEPTH - 1;
  SLOAD(SE, 0); asm volatile("s_waitcnt vmcnt(0)" ::: "memory"); SWRITE(0, SE); __syncthreads();
  qkt(pA0, pA1, K_lds, qr, r32, hi); MASK(pA0, pA1, 0); partialSM(pA0, pA1, m_reg, mnA, alA);
  SLOAD(SO, 1); if constexpr (SDEPTH == 2) { if (2 < NT) SLOAD(SE, 2); }
  SWAIT(); SWRITE(1, SO); __syncthreads();
  for (int j = 1; j + 1 < NT; j += 2) {
    SBAR(); qkt(pB0, pB1, (bf16*)((char*)K_lds + SHM_K), qr, r32, hi); MASK(pB0, pB1, j);
    finishSM(pA0, pA1, alA, l_reg, pa0, pa1, pa2, pa3); SBAR();
    SLOAD(SO, j + SDEPTH); SBAR();
    pv_d0(o, vb0, pa0, pa1, pa2, pa3); partialSM(pB0, pB1, m_reg, mnB, alB);
    __syncthreads(); SWAIT(); SWRITE(0, SE);
    RESC(alB); __syncthreads();
    SBAR(); qkt(pA0, pA1, K_lds, qr, r32, hi); MASK(pA0, pA1, j + 1);
    finishSM(pB0, pB1, alB, l_reg, pa0, pa1, pa2, pa3); SBAR();
    if (SDEPTH == 1 || j + 3 < NT) SLOAD(SE, j + 1 + SDEPTH); SBAR();
    pv_d0(o, vb0 + (int)SHM_V, pa0, pa1, pa2, pa3); partialSM(pA0, pA1, m_reg, mnA, alA);
    __syncthreads(); SWAIT(); SWRITE(1, SO);
    RESC(alA); __syncthreads();
  }
  SBAR(); qkt(pB0, pB1, (bf16*)((char*)K_lds + SHM_K), qr, r32, hi); MASK(pB0, pB1, NT - 1);
  finishSM(pA0, pA1, alA, l_reg, pa0, pa1, pa2, pa3); SBAR();
  pv_d0(o, vb0, pa0, pa1, pa2, pa3); partialSM(pB0, pB1, m_reg, mnB, alB);
  __syncthreads(); RESC(alB);
  finishSM(pB0, pB1, alB, l_reg, pa0, pa1, pa2, pa3); SBAR();
  pv_d0(o, vb0 + (int)SHM_V, pa0, pa1, pa2, pa3);
  l_reg += __builtin_amdgcn_exp2f(sinkv * 1.4426950408889634f - m_reg * (SCALE * 1.4426950408889634f));
  if (hi == 0) li_l[r32] = l_reg; asm volatile("s_waitcnt lgkmcnt(0)" ::: "memory");
  float rli[16];
#pragma unroll
  for (int r = 0; r < 16; ++r) rli[r] = __builtin_amdgcn_rcpf(li_l[crow(r, hi)]);
  bf16* Ow = Ob + (long)(wid * QBLK) * ldo;
#pragma unroll
  for (int r = 0; r < 16; ++r) { const int orow = crow(r, hi);
#pragma unroll
    for (int d0 = 0; d0 < 4; ++d0) { const float v = o[d0][r] * rli[r]; const unsigned ub = __float_as_uint(v); Ow[(long)orow * ldo + d0 * 32 + r32] = (bf16)((ub + 0x7fffu + ((ub >> 16) & 1u)) >> 16); } }
  __syncthreads();
#undef SLOAD
#undef SWRITE
#undef SWAIT
#undef RESC
#undef MASK
}
#undef KSWZ
#undef SBAR
}
constexpr int NWAVES = 8;
constexpr int DM = 2048, NCTX = 8192, NLAT = 4096, MTOK = NCTX + NLAT, DEPTH = 4, DIN = 3072, DFF = 5632, DLRU = 512;
constexpr size_t O_YP = 0, O_YS = (size_t)NCTX * DM, O_CK = O_YS + (size_t)NLAT * DM, O_CV = O_CK + (size_t)32 * 4 * 256 * 256, O_ST = O_CV + (size_t)32 * 4 * 256 * 256, O_END = O_ST + (size_t)32 * 4 * 2 * 512;
#ifndef MK_PER_PHASE
#define MK_PER_PHASE 0
#endif
constexpr size_t MiB = 1u << 20;
constexpr size_t al(size_t x) { return (x + MiB - 1) / MiB * MiB; }
constexpr size_t WS_CTL = 0, CTL_ZERO_BYTES = 1 * MiB;
constexpr size_t SZ_WIN = (size_t)DIN * DM * 2, SZ_WOUT = (size_t)DM * DM * 2, SZ_W1 = (size_t)2 * DFF * DM * 2, SZ_W2 = (size_t)DM * DFF * 2;
constexpr size_t WS_WIN = 1 * MiB, WS_WOUT = WS_WIN + al(DEPTH * SZ_WIN), WS_W1 = WS_WOUT + al(DEPTH * SZ_WOUT), WS_W2 = WS_W1 + al(DEPTH * SZ_W1);
constexpr size_t WS_GW = WS_W2 + al(DEPTH * SZ_W2);
constexpr size_t WS_PW = WS_GW + al((size_t)DEPTH * 2 * 2 * 512 * 128 * 2);
constexpr size_t WS_CKB = WS_PW + al((size_t)DEPTH * 4 * 128 * 128 * 2);
constexpr size_t WS_CVB = WS_CKB + al((size_t)2 * 4 * 512 * 256 * 2);
constexpr size_t WS_MODP = WS_CVB + al((size_t)2 * 4 * 512 * 256 * 2);
constexpr size_t WS_MODV = WS_MODP + al((size_t)16 * 4 * 3 * 12288 * 4);
constexpr size_t WS_ROPE = WS_MODV + al((size_t)4 * 3 * 12288 * 4);
constexpr size_t WS_SUMM = WS_ROPE + 1 * MiB;
constexpr size_t WS_LAB = WS_SUMM + al((size_t)192 * 2 * 512 * 8);
constexpr size_t WS_YF = WS_LAB + al((size_t)2 * 2 * NLAT * DLRU * 4);
constexpr size_t WS_X = WS_YF + al((size_t)NCTX * DLRU * 4);
constexpr size_t WS_H = WS_X + al((size_t)MTOK * DM * 4);
constexpr size_t WS_P = WS_H + al((size_t)MTOK * DM * 2);
constexpr size_t WS_MIX = WS_P + al((size_t)MTOK * DIN * 2);
constexpr size_t WS_ACT = WS_MIX + al((size_t)MTOK * DM * 2);
constexpr size_t WS_END = WS_ACT + al((size_t)MTOK * DFF * 2);
constexpr int CW_TMO = 0, CW_BAR = 4096;
constexpr int RING_OFF = 0, RING_BYTES = 131072;
constexpr int LDSCTL_OFF = RING_BYTES, MISC_OFF = LDSCTL_OFF + 320;
constexpr int LDS_BYTES = 147456;

#define GAS __attribute__((address_space(1)))
#define LAS __attribute__((address_space(3)))
typedef unsigned short bf16;
typedef unsigned v4u __attribute__((ext_vector_type(4)));
typedef float f32x4 __attribute__((ext_vector_type(4)));
typedef short bf16x8 __attribute__((ext_vector_type(8)));
#define LDS_WAIT() asm volatile("s_waitcnt lgkmcnt(0)" ::: "memory")
__device__ __forceinline__ unsigned f2bf(float f) { unsigned u = __builtin_bit_cast(unsigned, f); return (u + 0x7fffu + ((u >> 16) & 1u)) >> 16; }
__device__ __forceinline__ unsigned pk2(float lo, float hi) { return f2bf(lo) | (f2bf(hi) << 16); }
__device__ __forceinline__ float bf2f(unsigned short h) { return __uint_as_float((unsigned)h << 16); }
__device__ __forceinline__ float sigmoidf_(float x) { return __builtin_amdgcn_rcpf(1.0f + __builtin_amdgcn_exp2f(-1.4426950408889634f * x)); }
__device__ __forceinline__ float wave_sum(float v) {
#pragma unroll
    for (int o = 1; o < 64; o <<= 1) v += __shfl_xor(v, o);
    return v;
}
#define XB_TMO      128
#define XB_XCNT(j)  (256  + 64 * (j))
#define XB_XSUB(j)  (1280 + 64 * (j))
#define XB_XGEN(j)  (2304 + 64 * (j))
#define XB_TOP      3328
#define XB_TOPGEN   3392
#define XCD_BAR_WORDS 3456
#define XB_SPIN_CAP (1u << 18)

__device__ __forceinline__ unsigned xb_ld(unsigned* p)              { return __hip_atomic_load(p, __ATOMIC_RELAXED, __HIP_MEMORY_SCOPE_AGENT); }
__device__ __forceinline__ unsigned xb_add(unsigned* p, unsigned v) { return __hip_atomic_fetch_add(p, v, __ATOMIC_RELAXED, __HIP_MEMORY_SCOPE_AGENT); }
__device__ __forceinline__ unsigned xb_xcc_id() { return (unsigned)__builtin_amdgcn_s_getreg((3 << 11) | 20) & 0xFu; }
#define XB_SPIN(cond, bar) do { unsigned _sp = 0; while (cond) { __builtin_amdgcn_s_sleep(1); \
    if ((++_sp & 255u) == 0u) { if (xb_ld(&(bar)[XB_TMO])) break; if (_sp > XB_SPIN_CAP) { atomicAdd(&(bar)[XB_TMO], 1u); break; } } } } while (0)

struct XcdBarrier {
    unsigned* bar; unsigned x;
    volatile LAS unsigned* st;
};

__device__ __forceinline__ XcdBarrier xcd_barrier_post(unsigned* bar, volatile LAS unsigned* st) {
    XcdBarrier b; b.bar = bar; b.x = xb_xcc_id(); b.st = st;
    if (threadIdx.x == 0) (void)xb_add(&bar[XB_XCNT(b.x)], 1u);
    return b;
}
__device__ __forceinline__ void xcd_barrier_complete(unsigned* bar, unsigned x, unsigned& nloc, unsigned& nx) {
    const unsigned G = gridDim.x * gridDim.y * gridDim.z;
    unsigned sum, cnt, mine, sp = 0u;
    for (;;) {
        sum = 0u; cnt = 0u; mine = 0u;
#pragma unroll
        for (unsigned j = 0; j < 16; ++j) { const unsigned c = xb_ld(&bar[XB_XCNT(j)]); sum += c; cnt += (c > 0u) ? 1u : 0u; mine = (j == x) ? c : mine; }
        if (sum == G) break;
        __builtin_amdgcn_s_sleep(1);
        if ((++sp & 255u) == 0u) { if (xb_ld(&bar[XB_TMO])) break; if (sp > XB_SPIN_CAP) { atomicAdd(&bar[XB_TMO], 1u); break; } }
    }
    nloc = mine > 0u ? mine : 1u; nx = cnt > 0u ? cnt : 1u;
}

__device__ __forceinline__ void xcd_barrier(const XcdBarrier& b) {
    asm volatile("s_waitcnt vmcnt(0)" ::: "memory");
    __syncthreads();
    if (threadIdx.x == 0) {
        unsigned* bar = b.bar;
        __builtin_amdgcn_s_waitcnt(0);
        unsigned nloc = b.st[0], nx = b.st[1];
        if (nloc == 0u) { xcd_barrier_complete(bar, b.x, nloc, nx); b.st[0] = nloc; b.st[1] = nx; }
        const unsigned old = xb_add(&bar[XB_XSUB(b.x)], 1u);
        const unsigned gen = old / nloc;
        if (old + 1u == (gen + 1u) * nloc) {
            __builtin_amdgcn_fence(__ATOMIC_RELEASE, "agent");
            asm volatile("s_waitcnt vmcnt(0)" ::: "memory");
            const unsigned og = xb_add(&bar[XB_TOP], 1u);
            const unsigned tg = og / nx;
            if (og + 1u == (tg + 1u) * nx) xb_add(&bar[XB_TOPGEN], 1u);
            else XB_SPIN(xb_ld(&bar[XB_TOPGEN]) == tg, bar);
            __builtin_amdgcn_fence(__ATOMIC_ACQUIRE, "agent");
            xb_add(&bar[XB_XGEN(b.x)], 1u);
            asm volatile("s_waitcnt vmcnt(0)" ::: "memory");
        } else {
            XB_SPIN(xb_ld(&bar[XB_XGEN(b.x)]) == gen, bar);
            __builtin_amdgcn_fence(__ATOMIC_ACQUIRE, "agent");
            asm volatile("s_waitcnt vmcnt(0)" ::: "memory");
        }
    }
    __syncthreads();
}
struct Args { const float* in[26]; float* out; unsigned char* ws; int ph_lo, ph_hi; };

__device__ __forceinline__ int src_col(int kind, int n) {
    if (kind == 1) { if (n < 1280) { const int p = n & 127, j = p >> 1, s = p & 1; return (n & ~127) + (j >> 5) * 64 + s * 32 + (j & 31); } return n; }
    if (kind == 2) { const int pn = n >> 8, bj = (n >> 7) & 1, j = n & 127; return bj * DFF + pn * 128 + j; }
    return n;
}
__device__ __forceinline__ void p0_transpose_item(const float* W, int K, int N, bf16* WT, LAS float* scr, int item, int lane, int kind) {
    const int nblk = N / 32, kb = item / nblk, nb = item % nblk, k0 = 64 * kb, n0 = 32 * nb;
    const int sc = src_col(kind, n0 + (lane & 31));
#pragma unroll 8
    for (int i = 0; i < 32; ++i) { const int kk = 2 * i + (lane >> 5); scr[kk * 33 + (lane & 31)] = W[(size_t)(k0 + kk) * N + sc]; }
    LDS_WAIT(); asm volatile("" ::: "memory");
    const int c = lane & 7;
#pragma unroll
    for (int j = 0; j < 4; ++j) { const int n = (lane >> 3) + 8 * j; const LAS float* s = scr + (8 * c) * 33 + n;
        v4u o; o.x = pk2(s[0 * 33], s[1 * 33]); o.y = pk2(s[2 * 33], s[3 * 33]); o.z = pk2(s[4 * 33], s[5 * 33]); o.w = pk2(s[6 * 33], s[7 * 33]);
        *(GAS v4u*)(WT + (size_t)(n0 + n) * K + k0 + 8 * c) = o; }
    LDS_WAIT(); asm volatile("" ::: "memory");
}
constexpr int IT_WIN = (DM / 64) * (DIN / 32), IT_WOUT = (DM / 64) * (DM / 32), IT_W1 = (DM / 64) * (2 * DFF / 32), IT_W2 = (DFF / 64) * (DM / 32), IT_LAYER = IT_WIN + IT_WOUT + IT_W1 + IT_W2;

__device__ __forceinline__ void p0_prologue(const Args& a, LAS unsigned char* lds, int tid, int lane, int wave, int G) {
    unsigned char* ws = a.ws;
    LAS float* sil = (LAS float*)(lds + 69632);
    for (int e = tid; e < 3 * 2048; e += 512) { const int cd = e >> 11, k = e & 2047; const float v = cd == 0 ? a.in[6][k] : a.in[5][(cd - 1) * 2048 + k]; sil[e] = v * sigmoidf_(v); }
    __syncthreads();
    float* modp = (float*)(ws + WS_MODP);
    for (int it = blockIdx.x; it < 384; it += G) {
        const int l = it / 96, rem = it % 96, ks = rem / 6, cb = rem % 6, col = cb * 2048 + tid * 4;
        const float* Wp = a.in[7] + ((size_t)l * 2048 + ks * 128) * 12288 + col;
        f32x4 a0 = (f32x4){0.f, 0.f, 0.f, 0.f}, a1 = a0, a2 = a0;
#pragma unroll 8
        for (int k = 0; k < 128; ++k) { const f32x4 w = *(const f32x4*)(Wp + (size_t)k * 12288); a0 += sil[ks * 128 + k] * w; a1 += sil[2048 + ks * 128 + k] * w; a2 += sil[4096 + ks * 128 + k] * w; }
        float* o = modp + ((size_t)(ks * 4 + l) * 3) * 12288 + col;
        *(f32x4*)o = a0; *(f32x4*)(o + 12288) = a1; *(f32x4*)(o + 2 * 12288) = a2;
    }
    LAS float* scr = (LAS float*)(lds + wave * 8448);
    const int gw = blockIdx.x * NWAVES + wave, NGW = G * NWAVES;
    for (int it = gw; it < DEPTH * IT_LAYER; it += NGW) {
        const int l = it / IT_LAYER; int r = it % IT_LAYER;
        if (r < IT_WIN) { p0_transpose_item(a.in[11] + (size_t)l * DM * DIN, DM, DIN, (bf16*)(ws + WS_WIN + l * SZ_WIN), scr, r, lane, 1); continue; } r -= IT_WIN;
        if (r < IT_WOUT) { p0_transpose_item(a.in[22] + (size_t)l * DM * DM, DM, DM, (bf16*)(ws + WS_WOUT + l * SZ_WOUT), scr, r, lane, 0); continue; } r -= IT_WOUT;
        if (r < IT_W1) { p0_transpose_item(a.in[23] + (size_t)l * DM * 2 * DFF, DM, 2 * DFF, (bf16*)(ws + WS_W1 + l * SZ_W1), scr, r, lane, 2); continue; } r -= IT_W1;
        p0_transpose_item(a.in[24] + (size_t)l * DFF * DM, DFF, DM, (bf16*)(ws + WS_W2 + l * SZ_W2), scr, r, lane, 0);
    }
    const int gt = blockIdx.x * 512 + tid, NGT = G * 512;
    bf16* GW = (bf16*)(ws + WS_GW);
    for (int e = gt; e < DEPTH * 2 * 2 * 512 * 128; e += NGT) { const int k = e & 127, o = (e >> 7) & 511, g = (e >> 16) & 1, d = (e >> 17) & 1, l = e >> 18, n = o >> 7, dd = o & 127;
        GW[e] = (bf16)f2bf((g ? a.in[17] : a.in[15])[((size_t)((l * 2 + d) * 4 + n) * 128 + k) * 128 + dd]); }
    bf16* PW = (bf16*)(ws + WS_PW);
    for (int e = gt; e < DEPTH * 4 * 128 * 128; e += NGT) { const int k = e & 127, dd = (e >> 7) & 127, g = (e >> 14) & 3, l = e >> 16; PW[e] = (bf16)f2bf(a.in[20][((size_t)(l * 4 + g) * 128 + k) * 128 + dd]); }
    bf16* CKB = (bf16*)(ws + WS_CKB); bf16* CVB = (bf16*)(ws + WS_CVB);
    for (int e = gt; e < 2 * 4 * 512 * 256; e += NGT) { const int col = e & 255, rest = e >> 8, kvh = col >> 7, p = col & 127, j = p >> 1, s = p & 1, nat = (j >> 5) * 64 + s * 32 + (j & 31);
        CKB[e] = (bf16)f2bf(a.in[2][(size_t)rest * 256 + kvh * 128 + nat]); CVB[e] = (bf16)f2bf(a.in[3][e]); }
    float* rope = (float*)(ws + WS_ROPE);
    for (int e = gt; e < 2048; e += NGT) { const int p = e >> 5, i = e & 31; const float inv = __builtin_amdgcn_exp2f(-(float)i * 0.41524101186092029f); const float ang = (float)p * inv;
        double rev = (double)ang * 0.15915494309189535; rev -= (double)(long long)rev; const float rf = (float)rev;
        rope[e] = __builtin_amdgcn_cosf(rf); rope[2048 + e] = __builtin_amdgcn_sinf(rf); }
}
__device__ __forceinline__ void p1_modreduce(const Args& a, int tid, int G) {
    const float* modp = (const float*)(a.ws + WS_MODP); float* modv = (float*)(a.ws + WS_MODV);
    for (int e4 = blockIdx.x * 512 + tid; e4 < 4 * 3 * 12288 / 4; e4 += G * 512) { const int e = e4 * 4, n = e % 12288, lc = e / 12288, l = lc / 3, cd = lc % 3;
        f32x4 v = *(const f32x4*)(a.in[8] + l * 12288 + n);
#pragma unroll
        for (int ks = 0; ks < 16; ++ks) v += *(const f32x4*)(modp + ((size_t)(ks * 4 + l) * 3 + cd) * 12288 + n);
        *(f32x4*)(modv + e) = v; }
}
__device__ __forceinline__ void norm_phase(const float* xc, const float* xl, const float* gn, const float* modl, int sh_idx, int sc_idx, bf16* H, int gw, int NGW, int lane) {
    const int rpw = (MTOK + NGW - 1) / NGW; int ccur = -1; f32x4 ga[8], sh[8];
    for (int m = gw * rpw; m < (gw + 1) * rpw && m < MTOK; ++m) {
        const int cond = m < NCTX ? 0 : (m < NCTX + 2048 ? 1 : 2);
        if (cond != ccur) { ccur = cond; const float* sc = modl + cond * 12288 + sc_idx * 2048; const float* sf = modl + cond * 12288 + sh_idx * 2048;
#pragma unroll
            for (int j = 0; j < 8; ++j) { const f32x4 g = *(const f32x4*)(gn + 256 * j + 4 * lane), s = *(const f32x4*)(sc + 256 * j + 4 * lane); ga[j] = g * (1.0f + s); sh[j] = *(const f32x4*)(sf + 256 * j + 4 * lane); } }
        const float* xr = m < NCTX ? xc + (size_t)m * DM : xl + (size_t)(m - NCTX) * DM;
        f32x4 v[8]; float ss = 0.f;
#pragma unroll
        for (int j = 0; j < 8; ++j) { v[j] = *(const f32x4*)(xr + 256 * j + 4 * lane); ss += (v[j].x * v[j].x + v[j].y * v[j].y) + (v[j].z * v[j].z + v[j].w * v[j].w); }
        const float rstd = 1.0f / sqrtf(wave_sum(ss) * (1.0f / DM) + 1e-6f);
        unsigned long long* o8 = (unsigned long long*)(H + (size_t)m * DM) + lane;
#pragma unroll
        for (int j = 0; j < 8; ++j) { const f32x4 y = v[j] * rstd * ga[j] + sh[j]; o8[64 * j] = (unsigned long long)pk2(y.x, y.y) | ((unsigned long long)pk2(y.z, y.w) << 32); }
    }
}
__device__ __forceinline__ void final_norm_phase(const float* x, const float* gn, float* out, int gw, int NGW, int lane) {
    f32x4 ga[8];
#pragma unroll
    for (int j = 0; j < 8; ++j) ga[j] = *(const f32x4*)(gn + 256 * j + 4 * lane);
    for (int m = gw; m < MTOK; m += NGW) {
        const float* xr = x + (size_t)m * DM; f32x4 v[8]; float ss = 0.f;
#pragma unroll
        for (int j = 0; j < 8; ++j) { v[j] = *(const f32x4*)(xr + 256 * j + 4 * lane); ss += (v[j].x * v[j].x + v[j].y * v[j].y) + (v[j].z * v[j].z + v[j].w * v[j].w); }
        const float rstd = 1.0f / sqrtf(wave_sum(ss) * (1.0f / DM) + 1e-6f);
#pragma unroll
        for (int j = 0; j < 8; ++j) *(f32x4*)(out + (size_t)m * DM + 256 * j + 4 * lane) = v[j] * rstd * ga[j];
    }
}
struct SeqInfo { int T, seq, t0, seqrow0, nch, cc, chunk0; bool lat; };
__device__ __forceinline__ SeqInfo seq_info(int chunk) {
    SeqInfo s; const int r0 = chunk * 64;
    if (r0 < NCTX) { s.T = 256; s.seq = r0 >> 8; s.t0 = r0 & 255; s.seqrow0 = s.seq * 256; s.nch = 4; s.chunk0 = s.seq * 4; s.lat = false; }
    else { const int rr = r0 - NCTX; s.T = 2048; s.seq = rr >> 11; s.t0 = rr & 2047; s.seqrow0 = NCTX + s.seq * 2048; s.nch = 32; s.chunk0 = 128 + s.seq * 32; s.lat = true; }
    s.cc = s.t0 >> 6; return s;
}
constexpr int LU_UB = 0, LU_UF = 17408, LU_A = LU_UF + 33792, LU_B = LU_A + 33792, LU_END = LU_B + 33792;
static_assert(LU_END <= RING_BYTES, "LRU unit LDS");
__device__ __forceinline__ void lru_conv(const Args& a, LAS unsigned char* lds, int l, const SeqInfo& si, int nblk, int tid) {
    const bf16* P = (const bf16*)(a.ws + WS_P); LAS float* UF = (LAS float*)(lds + LU_UF);
    const int cg = tid & 15, tg = tid >> 4, c8 = cg * 8, cb = nblk * 128 + c8;
    float xw[5][8];
#pragma unroll
    for (int j = 0; j < 5; ++j) { const int tl = si.t0 + tg * 2 + j - 2;
        if (tl >= 0 && tl < si.T) { const bf16x8 v = *(const bf16x8*)(P + (size_t)(si.seqrow0 + tl) * DIN + 1536 + cb);
#pragma unroll
            for (int e = 0; e < 8; ++e) xw[j][e] = bf2f((unsigned short)v[e]); }
        else {
#pragma unroll
            for (int e = 0; e < 8; ++e) xw[j][e] = 0.f; } }
    float cw[4][8], cbias[8];
#pragma unroll
    for (int j = 0; j < 4; ++j) { const f32x4 w0 = *(const f32x4*)(a.in[13] + (size_t)(l * 4 + j) * 512 + cb), w1 = *(const f32x4*)(a.in[13] + (size_t)(l * 4 + j) * 512 + cb + 4);
        cw[j][0] = w0.x; cw[j][1] = w0.y; cw[j][2] = w0.z; cw[j][3] = w0.w; cw[j][4] = w1.x; cw[j][5] = w1.y; cw[j][6] = w1.z; cw[j][7] = w1.w; }
    { const f32x4 b0 = *(const f32x4*)(a.in[14] + l * 512 + cb), b1 = *(const f32x4*)(a.in[14] + l * 512 + cb + 4);
        cbias[0] = b0.x; cbias[1] = b0.y; cbias[2] = b0.z; cbias[3] = b0.w; cbias[4] = b1.x; cbias[5] = b1.y; cbias[6] = b1.z; cbias[7] = b1.w; }
#pragma unroll
    for (int q = 0; q < 2; ++q) { const int t = tg * 2 + q; float u[8];
#pragma unroll
        for (int e = 0; e < 8; ++e) u[e] = cbias[e] + cw[0][e] * xw[q][e] + cw[1][e] * xw[q + 1][e] + cw[2][e] * xw[q + 2][e] + cw[3][e] * xw[q + 3][e];
        *(LAS f32x4*)(UF + t * 132 + c8) = (f32x4){u[0], u[1], u[2], u[3]}; *(LAS f32x4*)(UF + t * 132 + c8 + 4) = (f32x4){u[4], u[5], u[6], u[7]};
        v4u w; w.x = pk2(u[0], u[1]); w.y = pk2(u[2], u[3]); w.z = pk2(u[4], u[5]); w.w = pk2(u[6], u[7]);
        *(LAS v4u*)(lds + LU_UB + t * 272 + c8 * 2) = w; }
}
__device__ __forceinline__ void lru_gates(const Args& a, LAS unsigned char* lds, int l, int nblk, int d, int lane, int wave) {
    const bf16* GW = (const bf16*)(a.ws + WS_GW);
    LAS float* UF = (LAS float*)(lds + LU_UF); LAS float* A_ = (LAS float*)(lds + LU_A); LAS float* B_ = (LAS float*)(lds + LU_B);
    const int q = lane >> 4, cl = lane & 15, ch = wave * 16 + cl, chg = nblk * 128 + ch;
    f32x4 acc[2][4];
#pragma unroll
    for (int g = 0; g < 2; ++g)
#pragma unroll
        for (int m = 0; m < 4; ++m) acc[g][m] = (f32x4){0.f, 0.f, 0.f, 0.f};
#pragma unroll
    for (int ks = 0; ks < 4; ++ks) {
        bf16x8 bw[2];
#pragma unroll
        for (int g = 0; g < 2; ++g) bw[g] = *(const bf16x8*)(GW + ((size_t)((l * 2 + d) * 2 + g) * 512 + chg) * 128 + ks * 32 + 8 * q);
#pragma unroll
        for (int m = 0; m < 4; ++m) { const bf16x8 au = *(const LAS bf16x8*)(lds + LU_UB + (m * 16 + cl) * 272 + (ks * 32 + 8 * q) * 2);
#pragma unroll
            for (int g = 0; g < 2; ++g) acc[g][m] = __builtin_amdgcn_mfma_f32_16x16x32_bf16(au, bw[g], acc[g][m], 0, 0, 0); }
    }
    const float bav = a.in[16][(l * 2 + d) * 512 + chg], bxv = a.in[18][(l * 2 + d) * 512 + chg], lamv = a.in[19][(l * 2 + d) * 512 + chg];
    const float ls8 = -8.0f * 1.4426950408889634f * log1pf(expf(-lamv));
#pragma unroll
    for (int m = 0; m < 4; ++m)
#pragma unroll
        for (int rg = 0; rg < 4; ++rg) { const int t = m * 16 + 4 * q + rg;
            const float r = sigmoidf_(acc[0][m][rg] + bav), ig = sigmoidf_(acc[1][m][rg] + bxv);
            const float l2 = ls8 * r, av = __builtin_amdgcn_exp2f(l2), x2 = 1.3862943611198906f * l2;
            const float om = x2 > -0.02f ? -x2 * (1.0f + 0.5f * x2 * (1.0f + x2 * 0.33333333f)) : 1.0f - av * av;
            const float bv = __builtin_amdgcn_sqrtf(om) * ig * UF[t * 132 + ch];
            A_[t * 132 + ch] = av; B_[t * 132 + ch] = bv; }
}
__device__ __forceinline__ void lru_out(const Args& a, const LAS float* Y, const LAS float* Y2, int r0, int nblk, int tid) {
    const bf16* P = (const bf16*)(a.ws + WS_P); bf16* mix = (bf16*)(a.ws + WS_MIX);
#pragma unroll
    for (int k = 0; k < 2; ++k) { const int i = tid + 512 * k, t = i >> 4, c8 = (i & 15) * 8;
        f32x4 y0 = *(const LAS f32x4*)(Y + t * 132 + c8), y1 = *(const LAS f32x4*)(Y + t * 132 + c8 + 4);
        if (Y2) { y0 += *(const LAS f32x4*)(Y2 + t * 132 + c8); y1 += *(const LAS f32x4*)(Y2 + t * 132 + c8 + 4); }
        const bf16x8 gv = *(const bf16x8*)(P + (size_t)(r0 + t) * DIN + 2048 + nblk * 128 + c8);
        float o[8];
#pragma unroll
        for (int e = 0; e < 8; ++e) { const float g = bf2f((unsigned short)gv[e]); const float z = 0.7978845608028654f * (g + 0.044715f * g * g * g); o[e] = (e < 4 ? y0[e] : y1[e - 4]) * g * sigmoidf_(2.0f * z); }
        v4u w; w.x = pk2(o[0], o[1]); w.y = pk2(o[2], o[3]); w.z = pk2(o[4], o[5]); w.w = pk2(o[6], o[7]);
        *(v4u*)(mix + (size_t)(r0 + t) * DM + 1024 + nblk * 128 + c8) = w; }
}
__device__ __forceinline__ void lru_lat_pass1(const Args& a, LAS unsigned char* lds, int l, int chunk, int nblk, int tid, int lane, int wave) {
    const SeqInfo si = seq_info(chunk); const int lrow0 = chunk * 64 - NCTX;
    float2* summ = (float2*)(a.ws + WS_SUMM); float* LAB = (float*)(a.ws + WS_LAB);
    LAS float* A_ = (LAS float*)(lds + LU_A); LAS float* B_ = (LAS float*)(lds + LU_B);
    lru_conv(a, lds, l, si, nblk, tid);
    __syncthreads();
#pragma unroll 1
    for (int d = 0; d < 2; ++d) {
        lru_gates(a, lds, l, nblk, d, lane, wave);
        __syncthreads();
        if (tid < 128) {
            float Ap = 1.f, Bp = 0.f;
#pragma unroll 16
            for (int i = 0; i < 64; ++i) { const int t = d ? 63 - i : i; const float av = A_[t * 132 + tid], bv = B_[t * 132 + tid]; Bp = av * Bp + bv; Ap *= av; }
            summ[(size_t)(chunk * 2 + d) * 512 + nblk * 128 + tid] = make_float2(Ap, Bp);
        }
        float* ga = LAB + ((size_t)(d * 2 + 0) * NLAT + lrow0) * 512 + nblk * 128; float* gb = LAB + ((size_t)(d * 2 + 1) * NLAT + lrow0) * 512 + nblk * 128;
#pragma unroll
        for (int k = 0; k < 4; ++k) { const int i = tid + 512 * k, t = i >> 5, c4 = (i & 31) * 4;
            *(f32x4*)(ga + (size_t)t * 512 + c4) = *(const LAS f32x4*)(A_ + t * 132 + c4); *(f32x4*)(gb + (size_t)t * 512 + c4) = *(const LAS f32x4*)(B_ + t * 132 + c4); }
        __syncthreads();
    }
}
__device__ __forceinline__ void lru_lat_pass2(const Args& a, LAS unsigned char* lds, int l, int chunk, int nblk, int tid) {
    const SeqInfo si = seq_info(chunk); const int r0 = chunk * 64, lrow0 = r0 - NCTX;
    const float2* summ = (const float2*)(a.ws + WS_SUMM); const float* LAB = (const float*)(a.ws + WS_LAB);
    LAS float* Y0 = (LAS float*)(lds + LU_A); LAS float* Y1 = (LAS float*)(lds + LU_B);
    if (tid < 256) {
        const int d = tid >> 7, c = tid & 127, c2 = nblk * 128 + c;
        float2 sv[32];
#pragma unroll
        for (int j = 0; j < 32; ++j) { const bool need = d == 0 ? (j < si.cc) : (j > si.cc); sv[j] = need ? summ[(size_t)((si.chunk0 + j) * 2 + d) * 512 + c2] : make_float2(1.f, 0.f); }
        float h = a.in[4][(size_t)((si.seq * 4 + l) * 2 + d) * 512 + c2];
        if (d == 0) {
#pragma unroll
            for (int j = 0; j < 32; ++j) h = sv[j].x * h + sv[j].y;
        } else {
#pragma unroll
            for (int j = 31; j >= 0; --j) h = sv[j].x * h + sv[j].y;
        }
        const float* ga = LAB + ((size_t)(d * 2 + 0) * NLAT + lrow0) * 512 + c2; const float* gb = LAB + ((size_t)(d * 2 + 1) * NLAT + lrow0) * 512 + c2;
        LAS float* Y = d ? Y1 : Y0;
#pragma unroll 1
        for (int i0 = 0; i0 < 64; i0 += 16) {
            float av[16], bv[16];
#pragma unroll
            for (int i = 0; i < 16; ++i) { const int t = d ? 63 - (i0 + i) : i0 + i; av[i] = ga[(size_t)t * 512]; bv[i] = gb[(size_t)t * 512]; }
#pragma unroll
            for (int i = 0; i < 16; ++i) { const int t = d ? 63 - (i0 + i) : i0 + i; h = av[i] * h + bv[i]; Y[t * 132 + c] = h; }
        }
    }
    __syncthreads();
    lru_out(a, Y0, Y1, r0, nblk, tid);
    __syncthreads();
}
__device__ __forceinline__ void lru_ctx_seq(const Args& a, LAS unsigned char* lds, int l, int seq, int nblk, int tid, int lane, int wave) {
    float* YF = (float*)(a.ws + WS_YF);
    LAS float* A_ = (LAS float*)(lds + LU_A); LAS float* B_ = (LAS float*)(lds + LU_B);
    const int c2 = nblk * 128 + tid;
    float h = 0.f;
#pragma unroll 1
    for (int cc = 0; cc < 4; ++cc) {
        const int chunk = seq * 4 + cc; const SeqInfo si = seq_info(chunk); const int r0 = chunk * 64;
        lru_conv(a, lds, l, si, nblk, tid);
        __syncthreads();
        lru_gates(a, lds, l, nblk, 0, lane, wave);
        __syncthreads();
        if (tid < 128) {
#pragma unroll 16
            for (int t = 0; t < 64; ++t) { h = A_[t * 132 + tid] * h + B_[t * 132 + tid]; YF[(size_t)(r0 + t) * 512 + c2] = h; }
        }
        __syncthreads();
    }
    if (tid < 128) a.out[O_ST + (size_t)((seq * 4 + l) * 2 + 0) * 512 + c2] = h;
    h = 0.f;
#pragma unroll 1
    for (int cc = 3; cc >= 0; --cc) {
        const int chunk = seq * 4 + cc; const SeqInfo si = seq_info(chunk); const int r0 = chunk * 64;
        lru_conv(a, lds, l, si, nblk, tid);
        __syncthreads();
        lru_gates(a, lds, l, nblk, 1, lane, wave);
        __syncthreads();
        if (tid < 128) {
#pragma unroll 1
            for (int i0 = 0; i0 < 64; i0 += 16) {
                float yf[16];
#pragma unroll
                for (int i = 0; i < 16; ++i) yf[i] = YF[(size_t)(r0 + 63 - (i0 + i)) * 512 + c2];
#pragma unroll
                for (int i = 0; i < 16; ++i) { const int t = 63 - (i0 + i); h = A_[t * 132 + tid] * h + B_[t * 132 + tid]; B_[t * 132 + tid] = yf[i] + h; }
            }
        }
        __syncthreads();
        lru_out(a, B_, nullptr, r0, nblk, tid);
        __syncthreads();
    }
    if (tid < 128) a.out[O_ST + (size_t)((seq * 4 + l) * 2 + 1) * 512 + c2] = h;
}
__device__ __forceinline__ void pool_unit(const Args& a, LAS unsigned char* lds, int l, int chunk, int g, int tid, int lane, int wave) {
    const SeqInfo si = seq_info(chunk); const int r0 = chunk * 64;
    const bf16* P = (const bf16*)(a.ws + WS_P); const bf16* PW = (const bf16*)(a.ws + WS_PW); bf16* mix = (bf16*)(a.ws + WS_MIX);
    {
        const int w2 = 1 << g, cg = tid & 15, tg = tid >> 4, c8 = cg * 8, colp = 2560 + g * 128 + c8;
#pragma unroll
        for (int qq = 0; qq < 2; ++qq) { const int t = tg * 2 + qq, tl = si.t0 + t; const int lo = tl - w2 > 0 ? tl - w2 : 0, hi = tl + w2 < si.T ? tl + w2 : si.T;
            float s[8];
#pragma unroll
            for (int e = 0; e < 8; ++e) s[e] = 0.f;
            for (int r = lo; r < hi; ++r) { const bf16x8 v = *(const bf16x8*)(P + (size_t)(si.seqrow0 + r) * DIN + colp);
#pragma unroll
                for (int e = 0; e < 8; ++e) s[e] += bf2f((unsigned short)v[e]); }
            const bf16x8 sv = *(const bf16x8*)(P + (size_t)(si.seqrow0 + tl) * DIN + colp); const float inv = 1.0f / (float)(hi - lo);
            float pz[8];
#pragma unroll
            for (int e = 0; e < 8; ++e) pz[e] = s[e] * inv - bf2f((unsigned short)sv[e]);
            v4u w; w.x = pk2(pz[0], pz[1]); w.y = pk2(pz[2], pz[3]); w.z = pk2(pz[4], pz[5]); w.w = pk2(pz[6], pz[7]);
            *(LAS v4u*)(lds + LU_UB + t * 272 + c8 * 2) = w; }
    }
    __syncthreads();
    const int q = lane >> 4, cl = lane & 15, dch = wave * 16 + cl;
    f32x4 acc[4];
#pragma unroll
    for (int m = 0; m < 4; ++m) acc[m] = (f32x4){0.f, 0.f, 0.f, 0.f};
#pragma unroll
    for (int ks = 0; ks < 4; ++ks) { const bf16x8 bw = *(const bf16x8*)(PW + ((size_t)(l * 4 + g) * 128 + dch) * 128 + ks * 32 + 8 * q);
#pragma unroll
        for (int m = 0; m < 4; ++m) { const bf16x8 au = *(const LAS bf16x8*)(lds + LU_UB + (m * 16 + cl) * 272 + (ks * 32 + 8 * q) * 2); acc[m] = __builtin_amdgcn_mfma_f32_16x16x32_bf16(au, bw, acc[m], 0, 0, 0); } }
    const float sc = a.in[21][l * 512 + g * 128 + dch];
#pragma unroll
    for (int m = 0; m < 4; ++m)
#pragma unroll
        for (int rg = 0; rg < 4; ++rg) { const int t = m * 16 + 4 * q + rg; mix[(size_t)(r0 + t) * DM + 1536 + g * 128 + dch] = (bf16)f2bf(acc[m][rg] * sc); }
    __syncthreads();
}
__device__ __forceinline__ void attn_ctx_unit(const Args& a, char* lds, int l, int i) {
    const int b = i >> 3, h = i & 7, kvh = h >> 2;
    const bf16* P = (const bf16*)(a.ws + WS_P); bf16* mix = (bf16*)(a.ws + WS_MIX);
    att::Src S; S.k0 = P + (size_t)(b * 256) * DIN + 1024 + kvh * 128; S.v0 = S.k0 + 256; S.ld0 = DIN; S.n0 = 4; S.k1 = S.k0; S.v1 = S.v0; S.ld1 = DIN; S.nt = 4; S.jb_lo = 0;
    att::attn_unit<false>(P + (size_t)(b * 256) * DIN + h * 128, DIN, S, a.in[12][l * 8 + h], mix + (size_t)(b * 256) * DM + h * 128, DM, lds);
}
__device__ __forceinline__ void attn_lat_unit(const Args& a, char* lds, int l, int i) {
    const int b = i >> 6, h = (i >> 3) & 7, qb = i & 7, kvh = h >> 2, q0 = qb * 256, rowbase = NCTX + b * 2048;
    const bf16* P = (const bf16*)(a.ws + WS_P); bf16* mix = (bf16*)(a.ws + WS_MIX);
    const bf16* CKB = (const bf16*)(a.ws + WS_CKB); const bf16* CVB = (const bf16*)(a.ws + WS_CVB);
    const int jb_lo = qb == 0 ? 2 : 0, jb_hi = qb == 7 ? 6 : 8;
    att::Src S; S.k0 = CKB + (size_t)((b * 4 + l) * 512) * 256 + kvh * 128; S.v0 = CVB + (size_t)((b * 4 + l) * 512) * 256 + kvh * 128; S.ld0 = 256; S.n0 = 8;
    S.k1 = P + (size_t)(rowbase + q0 - 128 + jb_lo * 64) * DIN + 1024 + kvh * 128; S.v1 = S.k1 + 256; S.ld1 = DIN; S.nt = 8 + jb_hi - jb_lo; S.jb_lo = jb_lo;
    att::attn_unit<true>(P + (size_t)(rowbase + q0) * DIN + h * 128, DIN, S, a.in[12][l * 8 + h], mix + (size_t)(rowbase + q0) * DM + h * 128, DM, lds);
}
constexpr int N_PHASES = 2 + 8 * DEPTH + 1;
#ifndef REP_PRO
#define REP_PRO 1
#endif
#ifndef REP_NORM
#define REP_NORM 1
#endif
#ifndef REP_G1
#define REP_G1 1
#endif
#ifndef REP_L1
#define REP_L1 1
#endif
#ifndef REP_ATT
#define REP_ATT 1
#endif
#ifndef REP_CSEQ
#define REP_CSEQ 1
#endif
#ifndef REP_L2
#define REP_L2 1
#endif
#ifndef REP_POOL
#define REP_POOL 1
#endif
#ifndef REP_G2
#define REP_G2 1
#endif
#ifndef REP_G3
#define REP_G3 1
#endif
#ifndef REP_G4
#define REP_G4 1
#endif
#define REPEAT(n) _Pragma("unroll 1") for (int rep_ = 0; rep_ < (n); ++rep_)
#define DUMMY ((float*)(ws + WS_END))
__device__ __forceinline__ int lista_index(int w, int s, int G) { const int i = w + s * G; return i < 256 ? i : -1; }
#if defined(__HIP_DEVICE_COMPILE__)
#define PHASE_ARGS const __attribute__((address_space(4))) Args* ap_ = (const __attribute__((address_space(4))) Args*)__builtin_amdgcn_kernarg_segment_ptr(); asm volatile("" : "+s"(ap_)); const Args a = *ap_;
#else
#define PHASE_ARGS const Args a = a_;
#endif
#define PHASE_LOCALS int tid = threadIdx.x; asm volatile("" : "+v"(tid)); const int lane = tid & 63, wave = __builtin_amdgcn_readfirstlane(tid >> 6); PHASE_ARGS \
    unsigned char* ws = a.ws; const int G = gridDim.x; const int gw = blockIdx.x * NWAVES + wave, NGW = G * NWAVES; (void)lane; (void)gw; (void)NGW; (void)ws;
__global__ void __launch_bounds__(NWAVES * 64, 2) fwd_kernel(Args a_) {
    extern __shared__ __attribute__((aligned(16))) unsigned char lds_raw[];
    LAS unsigned char* lds = (LAS unsigned char*)lds_raw;
    for (int u = threadIdx.x; u < (LDS_BYTES - LDSCTL_OFF) / 4; u += NWAVES * 64) ((LAS unsigned*)(lds + LDSCTL_OFF))[u] = 0u;
    __syncthreads();
#if !MK_PER_PHASE
    XcdBarrier bar = xcd_barrier_post((unsigned*)(a_.ws + WS_CTL) + CW_BAR, (volatile LAS unsigned*)(lds + MISC_OFF) + 8);
#define SEAM(k) do { if ((k) + 1 < hi) xcd_barrier(bar); } while (0)
#else
#define SEAM(k) do { } while (0)
#endif
    const int lo = a_.ph_lo, hi = a_.ph_hi;
#define IN(k) (lo <= (k) && (k) < hi)
#define XBUF ((float*)(ws + WS_X))
#define HB ((bf16*)(ws + WS_H))
#define PB ((bf16*)(ws + WS_P))
#define MIXB ((bf16*)(ws + WS_MIX))
#define ACTB ((bf16*)(ws + WS_ACT))
#define MODL ((const float*)(ws + WS_MODV) + (size_t)l * 3 * 12288)
#define ROPE ((const float*)(ws + WS_ROPE))
#define XC (l == 0 ? a.in[0] : (const float*)XBUF)
#define XL (l == 0 ? a.in[1] : (const float*)XBUF + (size_t)NCTX * DM)

#ifndef NO_PRO
    if (IN(0)) { REPEAT(REP_PRO) { PHASE_LOCALS p0_prologue(a, lds, tid, lane, wave, G); __syncthreads(); } SEAM(0); }
    if (IN(1)) { { PHASE_LOCALS p1_modreduce(a, tid, G); } SEAM(1); }
#endif
    for (int l = 0; l < DEPTH; ++l) {
        const int pb = 2 + 8 * l;
#ifndef NO_NORM
        if (IN(pb + 0)) { REPEAT(REP_NORM) { PHASE_LOCALS norm_phase(XC, XL, a.in[9] + l * DM, MODL, 0, 1, HB, gw, NGW, lane); } SEAM(pb + 0); }
#endif
#ifndef NO_G1
        if (IN(pb + 1)) {
            REPEAT(REP_G1) { PHASE_LOCALS
            pg8::Gemm g{HB, (const bf16*)(ws + WS_WIN + l * SZ_WIN), MTOK, DIN, DM}; pg8::StaticOrder S; S.init(MTOK, DIN, G, (int)blockIdx.x);
            pg8::EpiIn E{PB, a.out + O_CK, a.out + O_CV, ROPE, ROPE + 2048, l};
            pg8::gemm_phase<pg8::EpiIn, pg8::StaticOrder, true, true>(lds + RING_OFF, g, S, E); }
            SEAM(pb + 1);
        }
#endif
#ifndef NO_LRU1
        if (IN(pb + 2)) { REPEAT(REP_L1) { PHASE_LOCALS for (int u = blockIdx.x; u < 256; u += G) lru_lat_pass1(a, lds, l, 128 + (u >> 2), u & 3, tid, lane, wave); } SEAM(pb + 2); }
#endif
        if (IN(pb + 3)) {
#ifndef NO_ATT
            REPEAT(REP_ATT) { PHASE_LOCALS
            for (int s = 0;; ++s) { const int i = lista_index((int)blockIdx.x, s, G); if (i < 0) break; if (i < 128) attn_lat_unit(a, (char*)lds_raw, l, i); }
            for (int i = blockIdx.x; i < 256; i += G) attn_ctx_unit(a, (char*)lds_raw, l, i); }
            __syncthreads();
            REPEAT(REP_CSEQ) { PHASE_LOCALS
            for (int s = 0;; ++s) { const int i = lista_index((int)blockIdx.x, s, G); if (i < 0) break; if (i >= 128) lru_ctx_seq(a, lds, l, (i - 128) >> 2, (i - 128) & 3, tid, lane, wave); } }
#endif
            __syncthreads();
#ifndef NO_LRU2
            REPEAT(REP_L2) { PHASE_LOCALS for (int u = blockIdx.x; u < 256; u += G) lru_lat_pass2(a, lds, l, 128 + (u >> 2), u & 3, tid); }
#endif
#ifndef NO_POOL
            REPEAT(REP_POOL) { PHASE_LOCALS for (int u = blockIdx.x; u < 768; u += G) pool_unit(a, lds, l, u >> 2, u & 3, tid, lane, wave); }
#endif
            SEAM(pb + 3);
        }
#ifndef NO_G2
        if (IN(pb + 4)) {
            REPEAT(REP_G2) { PHASE_LOCALS
            pg8::Gemm g{MIXB, (const bf16*)(ws + WS_WOUT + l * SZ_WOUT), MTOK, DM, DM}; pg8::StaticOrder S; S.init(MTOK, DM, G, (int)blockIdx.x);
            pg8::EpiRes E{XC, XL, rep_ ? DUMMY : XBUF, MODL + 2 * 2048};
            pg8::gemm_phase<pg8::EpiRes, pg8::StaticOrder, true, true>(lds + RING_OFF, g, S, E); }
            SEAM(pb + 4);
        }
#endif
#ifndef NO_NORM
        if (IN(pb + 5)) { REPEAT(REP_NORM) { PHASE_LOCALS norm_phase(XBUF, XBUF + (size_t)NCTX * DM, a.in[10] + l * DM, MODL, 3, 4, HB, gw, NGW, lane); } SEAM(pb + 5); }
#endif
#ifndef NO_G3
        if (IN(pb + 6)) {
            REPEAT(REP_G3) { PHASE_LOCALS
            pg8::Gemm g{HB, (const bf16*)(ws + WS_W1 + l * SZ_W1), MTOK, 2 * DFF, DM}; pg8::StaticOrder S; S.init(MTOK, 2 * DFF, G, (int)blockIdx.x);
            pg8::EpiSwiGLU E{ACTB};
            pg8::gemm_phase<pg8::EpiSwiGLU, pg8::StaticOrder, true, true>(lds + RING_OFF, g, S, E); }
            SEAM(pb + 6);
        }
#endif
#ifndef NO_G4
        if (IN(pb + 7)) {
            REPEAT(REP_G4) { PHASE_LOCALS
            pg8::Gemm g{ACTB, (const bf16*)(ws + WS_W2 + l * SZ_W2), MTOK, DM, DFF}; pg8::StaticOrder S; S.init(MTOK, DM, G, (int)blockIdx.x);
            pg8::EpiRes E{XBUF, XBUF + (size_t)NCTX * DM, rep_ ? DUMMY : XBUF, MODL + 5 * 2048};
            pg8::gemm_phase<pg8::EpiRes, pg8::StaticOrder, true, true>(lds + RING_OFF, g, S, E); }
            SEAM(pb + 7);
        }
#endif
    }
    if (IN(N_PHASES - 1)) { PHASE_LOCALS final_norm_phase(XBUF, a.in[25], a.out + O_YP, gw, NGW, lane); }
#undef IN
#undef SEAM
}

extern "C" void kernel_launch(void* const* d_in, const int* in_sizes, int n_in, void* d_out, int out_size, void* d_ws, size_t ws_size, hipStream_t stream) {
    static int grid = 0;
    if (grid == 0) {
        if (n_in != 26 || (size_t)out_size != O_END || ws_size < WS_END + (size_t)MTOK * DM * 4) { fprintf(stderr, "kernel_launch: built for 26 inputs, %zu outputs, >= %zu bytes of workspace; got n_in %d, out %d, ws %zu; nothing launched\n", (size_t)O_END, (size_t)WS_END, n_in, out_size, ws_size); grid = -1; return; }
        int dev = 0, cus = 0, per_cu = 0;
        if (hipGetDevice(&dev) != hipSuccess || hipDeviceGetAttribute(&cus, hipDeviceAttributeMultiprocessorCount, dev) != hipSuccess) { fprintf(stderr, "kernel_launch: device query failed\n"); grid = -1; return; }
        if (hipFuncSetAttribute((const void*)fwd_kernel, hipFuncAttributeMaxDynamicSharedMemorySize, LDS_BYTES) != hipSuccess) { fprintf(stderr, "kernel_launch: hipFuncSetAttribute failed\n"); grid = -1; return; }
        if (hipOccupancyMaxActiveBlocksPerMultiprocessor(&per_cu, (const void*)fwd_kernel, NWAVES * 64, LDS_BYTES) != hipSuccess || per_cu < 1)
            fprintf(stderr, "kernel_launch: note: occupancy query reports %d workgroups per CU\n", per_cu);
        (void)hipGetLastError();
        grid = cus;
    }
    if (grid < 0) return;
    if (hipMemsetAsync((char*)d_ws + WS_CTL, 0, CTL_ZERO_BYTES, stream) != hipSuccess) { fprintf(stderr, "kernel_launch: memset failed\n"); return; }
    Args a{};
    for (int i = 0; i < 26; ++i) a.in[i] = (const float*)d_in[i];
    a.out = (float*)d_out; a.ws = (unsigned char*)d_ws;
#if MK_PER_PHASE
    for (int p = 0; p < N_PHASES; ++p) { a.ph_lo = p; a.ph_hi = p + 1; hipLaunchKernelGGL(fwd_kernel, dim3(grid), dim3(NWAVES * 64), LDS_BYTES, stream, a); }
#else
    a.ph_lo = 0; a.ph_hi = N_PHASES; hipLaunchKernelGGL(fwd_kernel, dim3(grid), dim3(NWAVES * 64), LDS_BYTES, stream, a);
#endif
    const hipError_t le = hipPeekAtLastError();
    if (le != hipSuccess) fprintf(stderr, "kernel_launch: launch failed: %s\n", hipGetErrorName(le));
}
```

```cpp
#include <hip/hip_runtime.h>
#include <cstdio>
#include <cstdint>
namespace pg8 {
#define PG8_LAS __attribute__((address_space(3)))
typedef unsigned short bf16_t;
typedef short bf16x8 __attribute__((ext_vector_type(8)));
typedef float f32x4 __attribute__((ext_vector_type(4)));
typedef unsigned u32x4 __attribute__((ext_vector_type(4)));
constexpr int BM = 256, BK = 64, HALF = 128, HTB = HALF * BK * 2  , STAGE_BYTES = 8 * HTB, NXCD = 8, WGM = 8;

__host__ __device__ __forceinline__ int lds_byte(int r, int c) { const int st = (r >> 4) * 2 + (c >> 5), rr = r & 15, cc = c & 31, ob = rr * 64 + cc * 2; return st * 1024 + (ob ^ (((ob >> 9) & 1) << 5)); }
__host__ __device__ __forceinline__ void stage_rc(int b, int& R, int& C) { const int st = b / 1024, sb = b % 1024, swz = sb ^ (((sb >> 9) & 1) << 5); R = (st >> 1) * 16 + swz / 64; C = (st & 1) * 32 + (swz % 64) / 2; }
__host__ __device__ __forceinline__ int perm32(int rho) { const int n = rho >> 4, i = rho & 15; return 8 * (i >> 2) + 4 * n + (i & 3); }

struct Unit { int pm, pn; };
struct Gemm { const bf16_t* A; const bf16_t* Bt; int M, N, K; };

struct StaticOrder {
    int nM, nN, nwg, G, c;
    __host__ __device__ void init(int M, int N, int G_, int c_) { nM = M / BM; nN = N / BM; nwg = nM * nN; G = G_; c = c_; }
    __host__ __device__ bool next(int i, Unit& u) const {
        const long L = (long)i * G + c; if (L >= nwg) return false;
        int wgid = (int)L; { const int q = nwg / NXCD, r = nwg % NXCD, xcd = wgid % NXCD, off = wgid / NXCD; wgid = (xcd < r ? xcd * (q + 1) : r * (q + 1) + (xcd - r) * q) + off; }
        const int nig = WGM * nN, gid = wgid / nig, fm = gid * WGM, gsz = (nM - fm) < WGM ? (nM - fm) : WGM;
        u.pm = fm + ((wgid % nig) % gsz); u.pn = (wgid % nig) / gsz; return true;
    }
    __device__ __forceinline__ void a_ready(const Unit&) const {}
    __device__ __forceinline__ void done(const Unit&) const {}
};
__device__ __forceinline__ unsigned cvt_pk_bf16(float lo, float hi) { unsigned r; asm volatile("v_cvt_pk_bf16_f32 %0, %1, %2" : "=v"(r) : "v"(lo), "v"(hi)); return r; }
typedef float f32x2 __attribute__((ext_vector_type(2)));
struct EpiIn {
    static constexpr bool PERM = true, AFTER_DRAIN = false;
    bf16_t* P; float* outk; float* outv; const float* rcs; const float* rsn; int layer;
    __device__ __forceinline__ void operator()(const f32x4 (&acc)[2][2][4][2], const Unit& u, int wr, int wc, int fr, int fq) const {
        const bool lat = u.pm >= 32; const bool rope = lat && (u.pn <= 4); const bool kout = (!lat) && (u.pn == 4), vout = (!lat) && (u.pn == 5);
        const int i0 = (wc & 1) * 16 + 4 * fq;
#pragma unroll
        for (int ai = 0; ai < 2; ++ai)
#pragma unroll
            for (int m = 0; m < 4; ++m) {
                const int row = u.pm * BM + ai * HALF + wr * 64 + m * 16 + fr;
                f32x4 cs4 = (f32x4){1.f, 1.f, 1.f, 1.f}, sn4 = (f32x4){0.f, 0.f, 0.f, 0.f};
                if (rope) { const int t = (row - 8192) & 2047; const int p = (wc >> 1) ? (t & 63) : (t >> 6); cs4 = *(const f32x4*)(rcs + p * 32 + i0); sn4 = *(const f32x4*)(rsn + p * 32 + i0); }
#pragma unroll
                for (int bj = 0; bj < 2; ++bj) {
                    f32x4 v0 = acc[ai][bj][m][0], v1 = acc[ai][bj][m][1];
                    if (kout) { float* d = outk + ((size_t)(((row >> 8) * 4 + layer) * 256 + (row & 255)) * 256 + bj * 128 + (wc >> 1) * 64 + (wc & 1) * 16 + 4 * fq);
                        *(f32x4*)d = (f32x4){v0[0], v0[2], v1[0], v1[2]}; *(f32x4*)(d + 32) = (f32x4){v0[1], v0[3], v1[1], v1[3]}; }
                    if (vout) { float* d = outv + ((size_t)(((row >> 8) * 4 + layer) * 256 + (row & 255)) * 256 + bj * 128 + wc * 32 + 8 * fq); *(f32x4*)d = v0; *(f32x4*)(d + 4) = v1; }
                    if (rope) {
                        const f32x4 a0 = v0, a1 = v1;
                        v0[0] = a0[0] * cs4[0] - a0[1] * sn4[0]; v0[1] = a0[1] * cs4[0] + a0[0] * sn4[0];
                        v0[2] = a0[2] * cs4[1] - a0[3] * sn4[1]; v0[3] = a0[3] * cs4[1] + a0[2] * sn4[1];
                        v1[0] = a1[0] * cs4[2] - a1[1] * sn4[2]; v1[1] = a1[1] * cs4[2] + a1[0] * sn4[2];
                        v1[2] = a1[2] * cs4[3] - a1[3] * sn4[3]; v1[3] = a1[3] * cs4[3] + a1[2] * sn4[3];
                    }
                    u32x4 w; w.x = cvt_pk_bf16(v0[0], v0[1]); w.y = cvt_pk_bf16(v0[2], v0[3]); w.z = cvt_pk_bf16(v1[0], v1[1]); w.w = cvt_pk_bf16(v1[2], v1[3]);
                    *(u32x4*)(P + (size_t)row * 3072 + u.pn * BM + bj * HALF + wc * 32 + 8 * fq) = w;
                }
            }
    }
};
struct EpiRes {
    static constexpr bool PERM = false, AFTER_DRAIN = false;
    const float* bctx; const float* blat; float* out; const float* gate;
    __device__ __forceinline__ void operator()(const f32x4 (&acc)[2][2][4][2], const Unit& u, int wr, int wc, int fr, int fq) const {
        const int cond = u.pm < 32 ? 0 : (u.pm < 40 ? 1 : 2);
        const float* g = gate + cond * 12288; const float* bs = u.pm < 32 ? bctx : blat - (size_t)8192 * 2048;
        const int col0 = u.pn * BM + wc * 32 + 4 * fq;
        f32x4 gv[2][2];
#pragma unroll
        for (int bj = 0; bj < 2; ++bj)
#pragma unroll
            for (int n = 0; n < 2; ++n) gv[bj][n] = *(const f32x4*)(g + col0 + bj * HALF + n * 16);
#pragma unroll
        for (int ai = 0; ai < 2; ++ai)
#pragma unroll
            for (int m = 0; m < 4; ++m) { const size_t off = (size_t)(u.pm * BM + ai * HALF + wr * 64 + m * 16 + fr) * 2048 + col0;
#pragma unroll
                for (int bj = 0; bj < 2; ++bj)
#pragma unroll
                    for (int n = 0; n < 2; ++n) { const f32x4 b = *(const f32x4*)(bs + off + bj * HALF + n * 16); *(f32x4*)(out + off + bj * HALF + n * 16) = b + gv[bj][n] * acc[ai][bj][m][n]; }
            }
    }
};
struct EpiSwiGLU {
    static constexpr bool PERM = true, AFTER_DRAIN = false;
    bf16_t* act;
    __device__ __forceinline__ float sl(float g, float u) const { return g * u * __builtin_amdgcn_rcpf(1.0f + __builtin_amdgcn_exp2f(-1.4426950408889634f * g)); }
    __device__ __forceinline__ void operator()(const f32x4 (&acc)[2][2][4][2], const Unit& u, int wr, int wc, int fr, int fq) const {
#pragma unroll
        for (int ai = 0; ai < 2; ++ai)
#pragma unroll
            for (int m = 0; m < 4; ++m) { const int row = u.pm * BM + ai * HALF + wr * 64 + m * 16 + fr;
                const f32x4 g0 = acc[ai][0][m][0], g1 = acc[ai][0][m][1], u0 = acc[ai][1][m][0], u1 = acc[ai][1][m][1];
                u32x4 w; w.x = cvt_pk_bf16(sl(g0[0], u0[0]), sl(g0[1], u0[1])); w.y = cvt_pk_bf16(sl(g0[2], u0[2]), sl(g0[3], u0[3]));
                w.z = cvt_pk_bf16(sl(g1[0], u1[0]), sl(g1[1], u1[1])); w.w = cvt_pk_bf16(sl(g1[2], u1[2]), sl(g1[3], u1[3]));
                *(u32x4*)(act + (size_t)row * 5632 + u.pn * HALF + wc * 32 + 8 * fq) = w; }
    }
};
template <class Epi, class Sched, bool ALIGN_EPI = false, bool SP2 = false>
__device__ __forceinline__ void gemm_phase(PG8_LAS unsigned char* lds, const Gemm g, const Sched& S, const Epi& E) {
    int tid_ = threadIdx.x; asm volatile("" : "+v"(tid_));
    const int tid = tid_, wid = __builtin_amdgcn_readfirstlane(tid >> 6), lane = tid & 63, wr = wid >> 2, wc = wid & 3, fr = lane & 15, fq = lane >> 4;
    const int K = g.K, nt = K / BK;
    unsigned voffA[2], voffB[2];
#pragma unroll
    for (int i = 0; i < 2; ++i) { int R, C; stage_rc(tid * 16 + i * 8192, R, C); const int Rb = Epi::PERM ? ((R & ~31) + perm32(R & 31)) : R;
        voffA[i] = (unsigned)(R * K + C) * 2u; voffB[i] = (unsigned)(Rb * K + C) * 2u; }
    const size_t kstep = (size_t)(BK * 2);
    const size_t hstep = (size_t)HALF * K * 2;
    const size_t tstep = 2 * hstep;
    const unsigned ldsw = (unsigned)wid * 1024u;
    const int aoff = lds_byte(wr * 64 + fr, fq * 8), boff = lds_byte(wc * 32 + fr, fq * 8);
#define PG8_SA(b, h) (((b) * 2 + (h)) * HTB)
#define PG8_SB(b, h) ((4 + (b) * 2 + (h)) * HTB)
#define PG8_STAGE(bufoff, gbase, voff) do { _Pragma("unroll") for (int _i = 0; _i < 2; ++_i) \
        __builtin_amdgcn_global_load_lds((const unsigned*)((const char*)(gbase) + (voff)[_i]), (PG8_LAS unsigned*)(lds + (bufoff) + ldsw + _i * 8192), 16, 0, 0); } while (0)
#define PG8_LDA(dst, b, h) do { _Pragma("unroll") for (int m = 0; m < 4; ++m) _Pragma("unroll") for (int k = 0; k < 2; ++k) dst[m][k] = *(const PG8_LAS bf16x8*)(lds + PG8_SA(b, h) + aoff + m * 2048 + k * 1024); } while (0)
#define PG8_LDB(dst, b, h) do { _Pragma("unroll") for (int n = 0; n < 2; ++n) _Pragma("unroll") for (int k = 0; k < 2; ++k) dst[n][k] = *(const PG8_LAS bf16x8*)(lds + PG8_SB(b, h) + boff + n * 2048 + k * 1024); } while (0)
#define PG8_MMA(ai, bj, At, Bt) do { __builtin_amdgcn_s_setprio(1); _Pragma("unroll") for (int m = 0; m < 4; ++m) _Pragma("unroll") for (int n = 0; n < 2; ++n) _Pragma("unroll") for (int k = 0; k < 2; ++k) \
        acc[ai][bj][m][n] = __builtin_amdgcn_mfma_f32_16x16x32_bf16(Bt[n][k], At[m][k], acc[ai][bj][m][n], 0, 0, 0); __builtin_amdgcn_s_setprio(0); } while (0)
#define PG8_WAIT_V(n) asm volatile("s_waitcnt vmcnt(" #n ")" ::: "memory")
#define PG8_WAIT_L(n) asm volatile("s_waitcnt lgkmcnt(" #n ")" ::: "memory")
#define PG8_BAR __builtin_amdgcn_s_barrier()
#define PG8_SCHED __builtin_amdgcn_sched_barrier(0)
    Unit cur, nxt; int ui = 0;
    if (!S.next(0, cur)) return;
    f32x4 acc[2][2][4][2];
#pragma unroll
    for (int a = 0; a < 2; ++a)
#pragma unroll
        for (int b = 0; b < 2; ++b)
#pragma unroll
            for (int m = 0; m < 4; ++m)
#pragma unroll
                for (int n = 0; n < 2; ++n) acc[a][b][m][n] = (f32x4){0.f, 0.f, 0.f, 0.f};
    bf16x8 At[4][2], B0[2][2], B1[2][2];
    const char* cA = (const char*)g.A + (size_t)cur.pm * tstep; const char* cB = (const char*)g.Bt + (size_t)cur.pn * tstep;
    S.a_ready(cur);
    if constexpr (SP2) {
        PG8_STAGE(PG8_SB(0, 0), cB, voffB); PG8_STAGE(PG8_SB(0, 1), cB + hstep, voffB); PG8_STAGE(PG8_SA(0, 0), cA, voffA); PG8_STAGE(PG8_SA(0, 1), cA + hstep, voffA);
        if (wr == 1) PG8_BAR;
        PG8_WAIT_V(2); PG8_BAR;
        PG8_STAGE(PG8_SB(1, 0), cB + kstep, voffB); PG8_STAGE(PG8_SA(1, 0), cA + kstep, voffA); PG8_STAGE(PG8_SB(1, 1), cB + hstep + kstep, voffB);
        PG8_WAIT_V(6); PG8_BAR;
    } else {
        PG8_STAGE(PG8_SB(0, 0), cB, voffB); PG8_STAGE(PG8_SA(0, 0), cA, voffA); PG8_STAGE(PG8_SB(0, 1), cB + hstep, voffB); PG8_STAGE(PG8_SA(0, 1), cA + hstep, voffA);
        if (wr == 1) PG8_BAR;
        PG8_WAIT_V(4); PG8_BAR;
        PG8_STAGE(PG8_SB(1, 0), cB + kstep, voffB); PG8_STAGE(PG8_SA(1, 0), cA + kstep, voffA); PG8_STAGE(PG8_SB(1, 1), cB + hstep + kstep, voffB);
        PG8_WAIT_V(6); PG8_BAR;
    }
    for (;;) {
        const bool has_next = S.next(ui + 1, nxt);
        const char* nA = has_next ? (const char*)g.A + (size_t)nxt.pm * tstep : cA; const char* nB = has_next ? (const char*)g.Bt + (size_t)nxt.pn * tstep : cB;
        for (int t = 0; t < nt; t += 2) {
            const bool last = (t == nt - 2);
            const char* a1 = cA + (size_t)(t + 1) * kstep;
            const char* a2 = last ? nA : cA + (size_t)(t + 2) * kstep; const char* b2 = last ? nB : cB + (size_t)(t + 2) * kstep;
            const char* a3 = a2 + kstep; const char* b3 = b2 + kstep;
            if (last && has_next) S.a_ready(nxt);
            if constexpr (SP2) {
            PG8_LDB(B0, 0, 0); PG8_LDB(B1, 0, 1); PG8_SCHED; PG8_LDA(At, 0, 0); PG8_STAGE(PG8_SA(1, 1), a1 + hstep, voffA);
            PG8_WAIT_V(8); PG8_WAIT_L(0); PG8_BAR; PG8_MMA(0, 0, At, B0); PG8_MMA(0, 1, At, B1); PG8_BAR; PG8_SCHED;
            PG8_LDA(At, 0, 1); PG8_STAGE(PG8_SB(0, 0), b2, voffB); PG8_STAGE(PG8_SB(0, 1), b2 + hstep, voffB); PG8_STAGE(PG8_SA(0, 0), a2, voffA);
            PG8_WAIT_V(8); PG8_WAIT_L(0); PG8_BAR; PG8_MMA(1, 0, At, B0); PG8_MMA(1, 1, At, B1); PG8_BAR; PG8_SCHED;
            PG8_LDB(B0, 1, 0); PG8_LDB(B1, 1, 1); PG8_SCHED; PG8_LDA(At, 1, 0); PG8_STAGE(PG8_SA(0, 1), a2 + hstep, voffA);
            PG8_WAIT_V(8); PG8_WAIT_L(0); PG8_BAR; PG8_MMA(0, 0, At, B0); PG8_MMA(0, 1, At, B1); PG8_BAR; PG8_SCHED;
            PG8_LDA(At, 1, 1); PG8_STAGE(PG8_SB(1, 0), b3, voffB); PG8_STAGE(PG8_SB(1, 1), b3 + hstep, voffB); PG8_STAGE(PG8_SA(1, 0), a3, voffA);
            PG8_WAIT_V(8); PG8_WAIT_L(0); PG8_BAR; PG8_MMA(1, 0, At, B0); PG8_MMA(1, 1, At, B1); PG8_BAR; PG8_SCHED;
            } else {
            PG8_LDB(B0, 0, 0); PG8_SCHED; PG8_LDA(At, 0, 0); PG8_STAGE(PG8_SA(1, 1), a1 + hstep, voffA);
            PG8_WAIT_L(8); PG8_BAR; PG8_WAIT_L(0); PG8_MMA(0, 0, At, B0); PG8_BAR; PG8_SCHED;
            PG8_LDB(B1, 0, 1); PG8_STAGE(PG8_SB(0, 0), b2, voffB);
            PG8_BAR; PG8_WAIT_L(0); PG8_MMA(0, 1, At, B1); PG8_BAR;
            PG8_LDA(At, 0, 1); PG8_STAGE(PG8_SA(0, 0), a2, voffA);
            PG8_BAR; PG8_WAIT_L(0); PG8_MMA(1, 0, At, B0); PG8_BAR; PG8_SCHED;
            PG8_STAGE(PG8_SB(0, 1), b2 + hstep, voffB);
            PG8_WAIT_V(6); PG8_BAR; PG8_MMA(1, 1, At, B1); PG8_BAR;
            PG8_LDB(B0, 1, 0); PG8_SCHED; PG8_LDA(At, 1, 0); PG8_STAGE(PG8_SA(0, 1), a2 + hstep, voffA);
            PG8_WAIT_L(8); PG8_BAR; PG8_WAIT_L(0); PG8_MMA(0, 0, At, B0); PG8_BAR; PG8_SCHED;
            PG8_LDB(B1, 1, 1); PG8_STAGE(PG8_SB(1, 0), b3, voffB);
            PG8_BAR; PG8_WAIT_L(0); PG8_MMA(0, 1, At, B1); PG8_BAR;
            PG8_LDA(At, 1, 1); PG8_STAGE(PG8_SA(1, 0), a3, voffA);
            PG8_BAR; PG8_WAIT_L(0); PG8_MMA(1, 0, At, B0); PG8_BAR; PG8_SCHED;
            PG8_STAGE(PG8_SB(1, 1), b3 + hstep, voffB);
            PG8_WAIT_V(6); PG8_BAR; PG8_MMA(1, 1, At, B1); PG8_BAR;
            }
        }
        if constexpr (ALIGN_EPI) { if (wr == 0) PG8_BAR; }
        if constexpr (!Epi::AFTER_DRAIN) { E(acc, cur, wr, wc, fr, fq); S.done(cur); }
        if (!has_next) break;
#pragma unroll
        for (int a = 0; a < 2; ++a)
#pragma unroll
            for (int b = 0; b < 2; ++b)
#pragma unroll
                for (int m = 0; m < 4; ++m)
#pragma unroll
                    for (int n = 0; n < 2; ++n) acc[a][b][m][n] = (f32x4){0.f, 0.f, 0.f, 0.f};
        cur = nxt; cA = nA; cB = nB; ++ui;
        if constexpr (ALIGN_EPI) { if (wr == 1) PG8_BAR; }
    }
    PG8_WAIT_V(0);
    if constexpr (!ALIGN_EPI) { if (wr == 0) PG8_BAR; }
    PG8_BAR;
    if constexpr (Epi::AFTER_DRAIN) { E.fused(acc, cur, wr, wc, fr, fq, lds, wid, lane); S.done(cur); }
#undef PG8_SA
#undef PG8_SB
#undef PG8_STAGE
#undef PG8_LDA
#undef PG8_LDB
#undef PG8_MMA
#undef PG8_WAIT_V
#undef PG8_WAIT_L
#undef PG8_BAR
#undef PG8_SCHED
}
}
namespace att {
typedef unsigned short bf16;
using bf16x8 = __attribute__((ext_vector_type(8))) short;
using s16x4  = __attribute__((ext_vector_type(4))) short;
using f32x16 = __attribute__((ext_vector_type(16))) float;
using u32x4  = __attribute__((ext_vector_type(4))) unsigned;
constexpr int   D = 128, NW = 8, QBLK = 32, KVBLK = 64;
constexpr float SCALE = 0.088388347648318440f;
constexpr float THR = 8.f;
#ifndef ATT_SDEPTH
#define ATT_SDEPTH 1
#endif
constexpr int SDEPTH = ATT_SDEPTH;
constexpr size_t SHM_V = KVBLK * D * 2, SHM_K = KVBLK * D * 2, SHM_ATTN = 2 * SHM_V + 2 * SHM_K + NW * 64 * 4;
#define KSWZ(row, colB) ((row) * 256 + ((colB) ^ (((row) & 7) << 4)))
#define SBAR() __builtin_amdgcn_sched_barrier(0)
__device__ __forceinline__ int crow(int r, int hi) { return (r & 3) + 8 * (r >> 2) + 4 * hi; }
__device__ __forceinline__ unsigned cvtpk(float lo, float hi) { unsigned r; asm volatile("v_cvt_pk_bf16_f32 %0, %1, %2" : "=v"(r) : "v"(lo), "v"(hi)); return r; }
__device__ __forceinline__ bf16x8 ld8(const bf16* p) { return *reinterpret_cast<const bf16x8*>(p); }

__device__ __forceinline__ void partialSM(f32x16& p0, f32x16& p1, float& m_reg, float& mn, float& alpha) {
  constexpr float C = SCALE * 1.4426950408889634f;
  float pmax = p0[0];
#pragma unroll
  for (int r = 1; r < 16; ++r) pmax = fmaxf(pmax, p0[r]);
#pragma unroll
  for (int r = 0; r < 16; ++r) pmax = fmaxf(pmax, p1[r]);
  { auto rr = __builtin_amdgcn_permlane32_swap(__float_as_uint(pmax), __float_as_uint(pmax), false, false);
    pmax = fmaxf(__uint_as_float(rr[0]), __uint_as_float(rr[1])); }
  if (__builtin_expect(__all(pmax - m_reg <= THR / SCALE), 1)) { mn = m_reg; alpha = 1.f; }
  else { mn = fmaxf(m_reg, pmax); alpha = __builtin_amdgcn_exp2f((m_reg - mn) * C); m_reg = mn; }
  float mnC = -mn * C;
#pragma unroll
  for (int r = 0; r < 16; ++r) p0[r] = fmaf(p0[r], C, mnC);
#pragma unroll
  for (int r = 0; r < 16; ++r) p1[r] = fmaf(p1[r], C, mnC);
#pragma unroll
  for (int r = 0; r < 16; ++r) p0[r] = __builtin_amdgcn_exp2f(p0[r]);
}
__device__ __forceinline__ void finishSM(f32x16& p0, f32x16& p1, float alpha, float& l_reg, bf16x8& pa0, bf16x8& pa1, bf16x8& pa2, bf16x8& pa3) {
#pragma unroll
  for (int r = 0; r < 16; ++r) p1[r] = __builtin_amdgcn_exp2f(p1[r]);
  float ps = 0;
#pragma unroll
  for (int r = 0; r < 16; ++r) ps += p0[r];
#pragma unroll
  for (int r = 0; r < 16; ++r) ps += p1[r];
  { auto rr = __builtin_amdgcn_permlane32_swap(__float_as_uint(ps), __float_as_uint(ps), false, false);
    ps = __uint_as_float(rr[0]) + __uint_as_float(rr[1]); }
  l_reg = l_reg * alpha + ps;
#define PK4(P, BASE, OUT) do { unsigned a0 = cvtpk(P[BASE + 0], P[BASE + 1]), a1 = cvtpk(P[BASE + 2], P[BASE + 3]);   \
    unsigned b0 = cvtpk(P[BASE + 4], P[BASE + 5]), b1 = cvtpk(P[BASE + 6], P[BASE + 7]);                              \
    auto r0 = __builtin_amdgcn_permlane32_swap(a0, b0, false, false); auto r1 = __builtin_amdgcn_permlane32_swap(a1, b1, false, false); \
    u32x4 w = {r0[0], r1[0], r0[1], r1[1]}; OUT = *reinterpret_cast<bf16x8*>(&w); } while (0)
  PK4(p0, 0, pa0); PK4(p0, 8, pa1); PK4(p1, 0, pa2); PK4(p1, 8, pa3);
#undef PK4
}
__device__ __forceinline__ void qkt(f32x16& p0, f32x16& p1, const bf16* Ks, const bf16x8* qr, int r32, int hi) {
  p0 = f32x16{}; p1 = f32x16{};
#pragma unroll
  for (int d0 = 0; d0 < 8; ++d0) { int cb = (d0 * 16 + hi * 8) * 2;
    bf16x8 b0 = *reinterpret_cast<const bf16x8*>((const char*)Ks + KSWZ(r32, cb));
    bf16x8 b1 = *reinterpret_cast<const bf16x8*>((const char*)Ks + KSWZ(32 + r32, cb));
    p0 = __builtin_amdgcn_mfma_f32_32x32x16_bf16(b0, qr[d0], p0, 0, 0, 0);
    p1 = __builtin_amdgcn_mfma_f32_32x32x16_bf16(b1, qr[d0], p1, 0, 0, 0); }
}
__device__ __forceinline__ void band_mask(f32x16& p0, f32x16& p1, int base, int hi) {
#pragma unroll
  for (int r = 0; r < 16; ++r) { const int kv = crow(r, hi); if ((unsigned)(base - kv) > 256u) p0[r] = -1e30f; if ((unsigned)(base - kv - 32) > 256u) p1[r] = -1e30f; }
}
__device__ __forceinline__ int v_st(int k, int c) { const int kk = (k & ~0xC) | ((k & 4) << 1) | ((k & 8) >> 1); return ((kk >> 3) * 4 + (c >> 5)) * 512 + ((kk & 7) * 32 + (c & 31)) * 2; }
__device__ __forceinline__ int v_rd_base(int lane) { return ((lane & 3) << 3) | (((lane >> 2) & 3) << 6) | (((lane >> 4) & 1) << 5) | (((lane >> 5) & 1) << 8); }
constexpr int v_rd_off(int d0, int ks, int half) { return d0 * 512 + ks * 4096 + half * 2048; }
template <int OFF> __device__ __forceinline__ s16x4 tr_read(int vb) {
  s16x4 r; asm volatile("ds_read_b64_tr_b16 %0, %1 offset:%2" : "=&v"(r) : "v"(vb), "i"(OFF) : "memory"); return r;
}
template <int D0> __device__ __forceinline__ void pv_one(f32x16& od, int vb, bf16x8 pa0, bf16x8 pa1, bf16x8 pa2, bf16x8 pa3) {
  const s16x4 l0 = tr_read<v_rd_off(D0, 0, 0)>(vb), h0 = tr_read<v_rd_off(D0, 0, 1)>(vb), l1 = tr_read<v_rd_off(D0, 1, 0)>(vb), h1 = tr_read<v_rd_off(D0, 1, 1)>(vb);
  const s16x4 l2 = tr_read<v_rd_off(D0, 2, 0)>(vb), h2 = tr_read<v_rd_off(D0, 2, 1)>(vb), l3 = tr_read<v_rd_off(D0, 3, 0)>(vb), h3 = tr_read<v_rd_off(D0, 3, 1)>(vb);
  asm volatile("s_waitcnt lgkmcnt(0)" ::: "memory"); SBAR();
#define PK(L, H) (bf16x8){L[0], L[1], L[2], L[3], H[0], H[1], H[2], H[3]}
  od = __builtin_amdgcn_mfma_f32_32x32x16_bf16(pa0, PK(l0, h0), od, 0, 0, 0);
  od = __builtin_amdgcn_mfma_f32_32x32x16_bf16(pa1, PK(l1, h1), od, 0, 0, 0);
  od = __builtin_amdgcn_mfma_f32_32x32x16_bf16(pa2, PK(l2, h2), od, 0, 0, 0);
  od = __builtin_amdgcn_mfma_f32_32x32x16_bf16(pa3, PK(l3, h3), od, 0, 0, 0);
#undef PK
}
__device__ __forceinline__ void pv_d0(f32x16* o, int vb, bf16x8 pa0, bf16x8 pa1, bf16x8 pa2, bf16x8 pa3) {
  pv_one<0>(o[0], vb, pa0, pa1, pa2, pa3); pv_one<1>(o[1], vb, pa0, pa1, pa2, pa3); pv_one<2>(o[2], vb, pa0, pa1, pa2, pa3); pv_one<3>(o[3], vb, pa0, pa1, pa2, pa3);
}
struct Src { const bf16* k0; const bf16* v0; int ld0; int n0; const bf16* k1; const bf16* v1; int ld1; int nt; int jb_lo; };

template <bool MASKED>
__device__ __forceinline__ void attn_unit(const bf16* __restrict__ Qb, int ldq, const Src S, float sinkv, bf16* __restrict__ Ob, int ldo, char* lds) {
  int tid_ = threadIdx.x; asm volatile("" : "+v"(tid_));
  const int tid = tid_, wid = tid >> 6, lane = tid & 63, r32 = lane & 31, hi = lane >> 5;
  bf16* V_lds = (bf16*)lds; bf16* K_lds = (bf16*)(lds + 2 * SHM_V);
  float* ws = (float*)(lds + 2 * SHM_V + 2 * SHM_K) + wid * 64; float* li_l = ws; float* al_l = ws + 32;
  float m_reg = -1e30f, l_reg = 0; f32x16 o[4] = {}; bf16x8 qr[8];
  const bf16* Qw = Qb + (long)(wid * QBLK + r32) * ldq + hi * 8;
#pragma unroll
  for (int d0 = 0; d0 < 8; ++d0) qr[d0] = ld8(Qw + d0 * 16);
  const int sr = tid >> 4, sc = (tid & 15) * 8, vst0 = v_st(sr, sc), vst1 = v_st(32 + sr, sc);
  const int vb0 = (int)(uintptr_t)V_lds + v_rd_base(lane);
  const int mbase = wid * QBLK + r32 + 256;
  const unsigned voff0 = (unsigned)(sr * S.ld0 + sc), voff1 = (unsigned)(sr * S.ld1 + sc);
  struct { bf16x8 vs0, vs1, ks0, ks1; } sr_[SDEPTH];
#define SLOAD(i, j) do { const int j_ = (j); const bool s0_ = j_ < S.n0; const int ld_ = s0_ ? S.ld0 : S.ld1; const long ro_ = (long)(s0_ ? j_ : j_ - S.n0) * KVBLK * ld_; \
    const bf16* kp_ = (s0_ ? S.k0 : S.k1) + ro_; const bf16* vp_ = (s0_ ? S.v0 : S.v1) + ro_; const bf16* kq_ = kp_ + 32l * ld_; const bf16* vq_ = vp_ + 32l * ld_; const unsigned vo_ = s0_ ? voff0 : voff1; \
    sr_[i].vs0 = ld8(vp_ + vo_); sr_[i].vs1 = ld8(vq_ + vo_); sr_[i].ks0 = ld8(kp_ + vo_); sr_[i].ks1 = ld8(kq_ + vo_); } while (0)
#define SWRITE(b, i) do { *(bf16x8*)((char*)V_lds + (b) * SHM_V + vst0) = sr_[i].vs0;          \
    *(bf16x8*)((char*)V_lds + (b) * SHM_V + vst1) = sr_[i].vs1; int kc = sc * 2;               \
    *(bf16x8*)((char*)K_lds + (b) * SHM_K + KSWZ(sr, kc)) = sr_[i].ks0;                       \
    *(bf16x8*)((char*)K_lds + (b) * SHM_K + KSWZ(32 + sr, kc)) = sr_[i].ks1; } while (0)
#define SWAIT() do { if constexpr (SDEPTH == 2) asm volatile("s_waitcnt vmcnt(4)" ::: "memory"); else asm volatile("s_waitcnt vmcnt(0)" ::: "memory"); } while (0)
#define RESC(a) do { if (__any((a) < 1.f)) { if (hi == 0) al_l[r32] = (a); asm volatile("s_waitcnt lgkmcnt(0)" ::: "memory"); \
    _Pragma("unroll") for (int d = 0; d < 4; ++d) _Pragma("unroll") for (int r = 0; r < 16; ++r) o[d][r] *= al_l[crow(r, hi)]; } } while (0)
#define MASK(P0, P1, j) do { if (MASKED) { const int j_ = (j); if (j_ >= S.n0) band_mask(P0, P1, mbase - 64 * (S.jb_lo + j_ - S.n0), hi); } } while (0)
  f32x16 pA0, pA1, pB0, pB1; float mnA, mnB, alA, alB; bf16x8 pa0, pa1, pa2, pa3; const int NT = S.nt;
  constexpr int SE = 0, SO = SDEPTH - 1;
  SLOAD(SE, 0); asm volatile("s_waitcnt vmcnt(0)" ::: "memory"); SWRITE(0, SE); __syncthreads();
  qkt(pA0, pA1, K_lds, qr, r32, hi); MASK(pA0, pA1, 0); partialSM(pA0, pA1, m_reg, mnA, alA);
  SLOAD(SO, 1); if constexpr (SDEPTH == 2) { if (2 < NT) SLOAD(SE, 2); }
  SWAIT(); SWRITE(1, SO); __syncthreads();
  for (int j = 1; j + 1 < NT; j += 2) {
    SBAR(); qkt(pB0, pB1, (bf16*)((char*)K_lds + SHM_K), qr, r32, hi); MASK(pB0, pB1, j);
    finishSM(pA0, pA1, alA, l_reg, pa0, pa1, pa2, pa3); SBAR();
    SLOAD(SO, j + SDEPTH); SBAR();
    pv_d0(o, vb0, pa0, pa1, pa2, pa3); partialSM(pB0, pB1, m_reg, mnB, alB);
    __syncthreads(); SWAIT(); SWRITE(0, SE);
    RESC(alB); __syncthreads();
    SBAR(); qkt(pA0, pA1, K_lds, qr, r32, hi); MASK(pA0, pA1, j + 1);
    finishSM(pB0, pB1, alB, l_reg, pa0, pa1, pa2, pa3); SBAR();
    if (SDEPTH == 1 || j + 3 < NT) SLOAD(SE, j + 1 + SDEPTH); SBAR();
    pv_d0(o, vb0 + (int)SHM_V, pa0, pa1, pa2, pa3); partialSM(pA0, pA1, m_reg, mnA, alA);
    __syncthreads(); SWAIT(); SWRITE(1, SO);
    RESC(alA); __syncthreads();
  }
  SBAR(); qkt(pB0, pB1, (bf16*)((char*)K_lds + SHM_K), qr, r32, hi); MASK(pB0, pB1, NT - 1);
  finishSM(pA0, pA1, alA, l_reg, pa0, pa1, pa2, pa3); SBAR();
  pv_d0(o, vb0, pa0, pa1, pa2, pa3); partialSM(pB0, pB1, m_reg, mnB, alB);
  __syncthreads(); RESC(alB);
  finishSM(pB0, pB1, alB, l_reg, pa0, pa1, pa2, pa3); SBAR();
  pv_d0(o, vb0 + (int)SHM_V, pa0, pa1, pa2, pa3);
  l_reg += __builtin_amdgcn_exp2f(sinkv * 1.4426950408889634f - m_reg * (SCALE * 1.4426950408889634f));
  if (hi == 0) li_l[r32] = l_reg; asm volatile("s_waitcnt lgkmcnt(0)" ::: "memory");
  float rli[16];
#pragma unroll
  for (int r = 0; r < 16; ++r) rli[r] = __builtin_amdgcn_rcpf(li_l[crow(r, hi)]);
  bf16* Ow = Ob + (long)(wid * QBLK) * ldo;
#pragma unroll
  for (int r = 0; r < 16; ++r) { const int orow = crow(r, hi);
#pragma unroll
    for (int d0 = 0; d0 < 4; ++d0) { const float v = o[d0][r] * rli[r]; const unsigned ub = __float_as_uint(v); Ow[(long)orow * ldo + d0 * 32 + r32] = (bf16)((ub + 0x7fffu + ((ub >> 16) & 1u)) >> 16); } }
  __syncthreads();
#undef SLOAD
#undef SWRITE
#undef SWAIT
#undef RESC
#undef MASK
}
#undef KSWZ
#undef SBAR
}
constexpr int NWAVES = 8;
constexpr int DM = 2048, NCTX = 8192, NLAT = 4096, MTOK = NCTX + NLAT, DEPTH = 4, DIN = 3072, DFF = 5632, DLRU = 512;
constexpr size_t O_YP = 0, O_YS = (size_t)NCTX * DM, O_CK = O_YS + (size_t)NLAT * DM, O_CV = O_CK + (size_t)32 * 4 * 256 * 256, O_ST = O_CV + (size_t)32 * 4 * 256 * 256, O_END = O_ST + (size_t)32 * 4 * 2 * 512;
#ifndef MK_PER_PHASE
#define MK_PER_PHASE 0
#endif
constexpr size_t MiB = 1u << 20;
constexpr size_t al(size_t x) { return (x + MiB - 1) / MiB * MiB; }
constexpr size_t WS_CTL = 0, CTL_ZERO_BYTES = 1 * MiB;
constexpr size_t SZ_WIN = (size_t)DIN * DM * 2, SZ_WOUT = (size_t)DM * DM * 2, SZ_W1 = (size_t)2 * DFF * DM * 2, SZ_W2 = (size_t)DM * DFF * 2;
constexpr size_t WS_WIN = 1 * MiB, WS_WOUT = WS_WIN + al(DEPTH * SZ_WIN), WS_W1 = WS_WOUT + al(DEPTH * SZ_WOUT), WS_W2 = WS_W1 + al(DEPTH * SZ_W1);
constexpr size_t WS_GW = WS_W2 + al(DEPTH * SZ_W2);
constexpr size_t WS_PW = WS_GW + al((size_t)DEPTH * 2 * 2 * 512 * 128 * 2);
constexpr size_t WS_CKB = WS_PW + al((size_t)DEPTH * 4 * 128 * 128 * 2);
constexpr size_t WS_CVB = WS_CKB + al((size_t)2 * 4 * 512 * 256 * 2);
constexpr size_t WS_MODP = WS_CVB + al((size_t)2 * 4 * 512 * 256 * 2);
constexpr size_t WS_MODV = WS_MODP + al((size_t)16 * 4 * 3 * 12288 * 4);
constexpr size_t WS_ROPE = WS_MODV + al((size_t)4 * 3 * 12288 * 4);
constexpr size_t WS_SUMM = WS_ROPE + 1 * MiB;
constexpr size_t WS_LAB = WS_SUMM + al((size_t)192 * 2 * 512 * 8);
constexpr size_t WS_YF = WS_LAB + al((size_t)2 * 2 * NLAT * DLRU * 4);
constexpr size_t WS_X = WS_YF + al((size_t)NCTX * DLRU * 4);
constexpr size_t WS_H = WS_X + al((size_t)MTOK * DM * 4);
constexpr size_t WS_P = WS_H + al((size_t)MTOK * DM * 2);
constexpr size_t WS_MIX = WS_P + al((size_t)MTOK * DIN * 2);
constexpr size_t WS_ACT = WS_MIX + al((size_t)MTOK * DM * 2);
constexpr size_t WS_END = WS_ACT + al((size_t)MTOK * DFF * 2);
constexpr int CW_TMO = 0, CW_BAR = 4096;
constexpr int RING_OFF = 0, RING_BYTES = 131072;
constexpr int LDSCTL_OFF = RING_BYTES, MISC_OFF = LDSCTL_OFF + 320;
constexpr int LDS_BYTES = 147456;

#define GAS __attribute__((address_space(1)))
#define LAS __attribute__((address_space(3)))
typedef unsigned short bf16;
typedef unsigned v4u __attribute__((ext_vector_type(4)));
typedef float f32x4 __attribute__((ext_vector_type(4)));
typedef short bf16x8 __attribute__((ext_vector_type(8)));
#define LDS_WAIT() asm volatile("s_waitcnt lgkmcnt(0)" ::: "memory")
__device__ __forceinline__ unsigned f2bf(float f) { unsigned u = __builtin_bit_cast(unsigned, f); return (u + 0x7fffu + ((u >> 16) & 1u)) >> 16; }
__device__ __forceinline__ unsigned pk2(float lo, float hi) { return f2bf(lo) | (f2bf(hi) << 16); }
__device__ __forceinline__ float bf2f(unsigned short h) { return __uint_as_float((unsigned)h << 16); }
__device__ __forceinline__ float sigmoidf_(float x) { return __builtin_amdgcn_rcpf(1.0f + __builtin_amdgcn_exp2f(-1.4426950408889634f * x)); }
__device__ __forceinline__ float wave_sum(float v) {
#pragma unroll
    for (int o = 1; o < 64; o <<= 1) v += __shfl_xor(v, o);
    return v;
}
#define XB_TMO      128
#define XB_XCNT(j)  (256  + 64 * (j))
#define XB_XSUB(j)  (1280 + 64 * (j))
#define XB_XGEN(j)  (2304 + 64 * (j))
#define XB_TOP      3328
#define XB_TOPGEN   3392
#define XCD_BAR_WORDS 3456
#define XB_SPIN_CAP (1u << 18)

__device__ __forceinline__ unsigned xb_ld(unsigned* p)              { return __hip_atomic_load(p, __ATOMIC_RELAXED, __HIP_MEMORY_SCOPE_AGENT); }
__device__ __forceinline__ unsigned xb_add(unsigned* p, unsigned v) { return __hip_atomic_fetch_add(p, v, __ATOMIC_RELAXED, __HIP_MEMORY_SCOPE_AGENT); }
__device__ __forceinline__ unsigned xb_xcc_id() { return (unsigned)__builtin_amdgcn_s_getreg((3 << 11) | 20) & 0xFu; }
#define XB_SPIN(cond, bar) do { unsigned _sp = 0; while (cond) { __builtin_amdgcn_s_sleep(1); \
    if ((++_sp & 255u) == 0u) { if (xb_ld(&(bar)[XB_TMO])) break; if (_sp > XB_SPIN_CAP) { atomicAdd(&(bar)[XB_TMO], 1u); break; } } } } while (0)

struct XcdBarrier {
    unsigned* bar; unsigned x;
    volatile LAS unsigned* st;
};

__device__ __forceinline__ XcdBarrier xcd_barrier_post(unsigned* bar, volatile LAS unsigned* st) {
    XcdBarrier b; b.bar = bar; b.x = xb_xcc_id(); b.st = st;
    if (threadIdx.x == 0) (void)xb_add(&bar[XB_XCNT(b.x)], 1u);
    return b;
}
__device__ __forceinline__ void xcd_barrier_complete(unsigned* bar, unsigned x, unsigned& nloc, unsigned& nx) {
    const unsigned G = gridDim.x * gridDim.y * gridDim.z;
    unsigned sum, cnt, mine, sp = 0u;
    for (;;) {
        sum = 0u; cnt = 0u; mine = 0u;
#pragma unroll
        for (unsigned j = 0; j < 16; ++j) { const unsigned c = xb_ld(&bar[XB_XCNT(j)]); sum += c; cnt += (c > 0u) ? 1u : 0u; mine = (j == x) ? c : mine; }
        if (sum == G) break;
        __builtin_amdgcn_s_sleep(1);
        if ((++sp & 255u) == 0u) { if (xb_ld(&bar[XB_TMO])) break; if (sp > XB_SPIN_CAP) { atomicAdd(&bar[XB_TMO], 1u); break; } }
    }
    nloc = mine > 0u ? mine : 1u; nx = cnt > 0u ? cnt : 1u;
}

__device__ __forceinline__ void xcd_barrier(const XcdBarrier& b) {
    asm volatile("s_waitcnt vmcnt(0)" ::: "memory");
    __syncthreads();
    if (threadIdx.x == 0) {
        unsigned* bar = b.bar;
        __builtin_amdgcn_s_waitcnt(0);
        unsigned nloc = b.st[0], nx = b.st[1];
        if (nloc == 0u) { xcd_barrier_complete(bar, b.x, nloc, nx); b.st[0] = nloc; b.st[1] = nx; }
        const unsigned old = xb_add(&bar[XB_XSUB(b.x)], 1u);
        const unsigned gen = old / nloc;
        if (old + 1u == (gen + 1u) * nloc) {
            __builtin_amdgcn_fence(__ATOMIC_RELEASE, "agent");
            asm volatile("s_waitcnt vmcnt(0)" ::: "memory");
            const unsigned og = xb_add(&bar[XB_TOP], 1u);
            const unsigned tg = og / nx;
            if (og + 1u == (tg + 1u) * nx) xb_add(&bar[XB_TOPGEN], 1u);
            else XB_SPIN(xb_ld(&bar[XB_TOPGEN]) == tg, bar);
            __builtin_amdgcn_fence(__ATOMIC_ACQUIRE, "agent");
            xb_add(&bar[XB_XGEN(b.x)], 1u);
            asm volatile("s_waitcnt vmcnt(0)" ::: "memory");
        } else {
            XB_SPIN(xb_ld(&bar[XB_XGEN(b.x)]) == gen, bar);
            __builtin_amdgcn_fence(__ATOMIC_ACQUIRE, "agent");
            asm volatile("s_waitcnt vmcnt(0)" ::: "memory");
        }
    }
    __syncthreads();
}
struct Args { const float* in[26]; float* out; unsigned char* ws; int ph_lo, ph_hi; };

__device__ __forceinline__ int dst_base(int kind, int c0) { if (kind == 2) { const int bj = c0 / DFF, jj = c0 % DFF; return (jj >> 7) * 256 + bj * 128 + (jj & 127); } return c0; }
__device__ __forceinline__ void p0_transpose_item(const float* W, int K, int N, bf16* WT, LAS unsigned short* scr, int item, int lane, int kind) {
    const int nblk = N / 64, kb = item / nblk, nb = item % nblk, k0 = 64 * kb, c0 = 64 * nb;
    const bool perm = (kind == 1) && (c0 < 1280);
    const int kr = lane >> 4, cq = lane & 15;
    f32x4 v[16];
#pragma unroll
    for (int i = 0; i < 16; ++i) v[i] = __builtin_nontemporal_load((const f32x4*)(W + (size_t)(k0 + 4 * i + kr) * N + c0 + 4 * cq));
    int dl[4];
#pragma unroll
    for (int e = 0; e < 4; ++e) { const int cl = 4 * cq + e; dl[e] = perm ? 2 * (cl & 31) + (cl >> 5) : cl; }
#pragma unroll
    for (int i = 0; i < 16; ++i) { const int k = 4 * i + kr;
        scr[dl[0] * 68 + k] = (unsigned short)f2bf(v[i].x); scr[dl[1] * 68 + k] = (unsigned short)f2bf(v[i].y); scr[dl[2] * 68 + k] = (unsigned short)f2bf(v[i].z); scr[dl[3] * 68 + k] = (unsigned short)f2bf(v[i].w); }
    LDS_WAIT(); asm volatile("" ::: "memory");
    const int nb2 = dst_base(kind, c0), ch = lane & 7;
#pragma unroll
    for (int r = 0; r < 8; ++r) { const int n = 8 * r + (lane >> 3);
        const LAS unsigned* sp = (const LAS unsigned*)(scr + n * 68 + 8 * ch);
        v4u o; o.x = sp[0]; o.y = sp[1]; o.z = sp[2]; o.w = sp[3];
        __builtin_nontemporal_store(o, (GAS v4u*)(WT + (size_t)(nb2 + n) * K + k0 + 8 * ch)); }
    LDS_WAIT(); asm volatile("" ::: "memory");
}
constexpr int IT_WIN = (DM / 64) * (DIN / 64), IT_WOUT = (DM / 64) * (DM / 64), IT_W1 = (DM / 64) * (2 * DFF / 64), IT_W2 = (DFF / 64) * (DM / 64), IT_LAYER = IT_WIN + IT_WOUT + IT_W1 + IT_W2;
__device__ __forceinline__ void convert_layer_weights(const Args& a, LAS unsigned char* lds, int l, int it_lo, int it_hi, int rank, int nranks, int lane, int wave) {
    unsigned char* ws = a.ws; LAS unsigned short* scr = (LAS unsigned short*)(lds + wave * 8704);
    for (int r0 = it_lo + rank; r0 < it_hi; r0 += nranks) {
        int r = r0;
        if (r < IT_WIN) { p0_transpose_item(a.in[11] + (size_t)l * DM * DIN, DM, DIN, (bf16*)(ws + WS_WIN + l * SZ_WIN), scr, r, lane, 1); continue; } r -= IT_WIN;
        if (r < IT_WOUT) { p0_transpose_item(a.in[22] + (size_t)l * DM * DM, DM, DM, (bf16*)(ws + WS_WOUT + l * SZ_WOUT), scr, r, lane, 0); continue; } r -= IT_WOUT;
        if (r < IT_W1) { p0_transpose_item(a.in[23] + (size_t)l * DM * 2 * DFF, DM, 2 * DFF, (bf16*)(ws + WS_W1 + l * SZ_W1), scr, r, lane, 2); continue; } r -= IT_W1;
        p0_transpose_item(a.in[24] + (size_t)l * DFF * DM, DFF, DM, (bf16*)(ws + WS_W2 + l * SZ_W2), scr, r, lane, 0);
    }
}
__device__ __forceinline__ void mod_partials(const Args& a, LAS unsigned char* lds, int l, int rank, int nranks, int tid) {
    LAS float* sil = (LAS float*)(lds + 69632);
    for (int e = tid; e < 3 * 2048; e += 512) { const int cd = e >> 11, k = e & 2047; const float v = cd == 0 ? a.in[6][k] : a.in[5][(cd - 1) * 2048 + k]; sil[e] = v * sigmoidf_(v); }
    __syncthreads();
    float* modp = (float*)(a.ws + WS_MODP);
    for (int it = rank; it < 96; it += nranks) {
        const int ks = it / 6, cb = it % 6, col = cb * 2048 + tid * 4;
        const float* Wp = a.in[7] + ((size_t)l * 2048 + ks * 128) * 12288 + col;
        f32x4 a0 = (f32x4){0.f, 0.f, 0.f, 0.f}, a1 = a0, a2 = a0;
#pragma unroll 8
        for (int k = 0; k < 128; ++k) { const f32x4 w = __builtin_nontemporal_load((const f32x4*)(Wp + (size_t)k * 12288)); a0 += sil[ks * 128 + k] * w; a1 += sil[2048 + ks * 128 + k] * w; a2 += sil[4096 + ks * 128 + k] * w; }
        float* o = modp + ((size_t)(ks * 4 + l) * 3) * 12288 + col;
        *(f32x4*)o = a0; *(f32x4*)(o + 12288) = a1; *(f32x4*)(o + 2 * 12288) = a2;
    }
    __syncthreads();
}
__device__ __forceinline__ void mod_reduce(const Args& a, int l, int rank, int nranks) {
    const float* modp = (const float*)(a.ws + WS_MODP); float* modv = (float*)(a.ws + WS_MODV);
    for (int e4 = rank; e4 < 3 * 12288 / 4; e4 += nranks) { const int e = e4 * 4, n = e % 12288, cd = e / 12288;
        f32x4 v = *(const f32x4*)(a.in[8] + l * 12288 + n);
#pragma unroll
        for (int ks = 0; ks < 16; ++ks) v += *(const f32x4*)(modp + ((size_t)(ks * 4 + l) * 3 + cd) * 12288 + n);
        *(f32x4*)(modv + (size_t)l * 3 * 12288 + e) = v; }
}
__device__ __forceinline__ void p0_prologue(const Args& a, LAS unsigned char* lds, int tid, int lane, int wave, int G) {
    unsigned char* ws = a.ws;
    mod_partials(a, lds, 0, (int)blockIdx.x, G, tid);
    convert_layer_weights(a, lds, 0, 0, IT_LAYER, (int)blockIdx.x * NWAVES + wave, G * NWAVES, lane, wave);
    const int gt = blockIdx.x * 512 + tid, NGT = G * 512;
    bf16* GW = (bf16*)(ws + WS_GW);
    for (int e = gt; e < DEPTH * 2 * 2 * 512 * 128; e += NGT) { const int k = e & 127, o = (e >> 7) & 511, g = (e >> 16) & 1, d = (e >> 17) & 1, l = e >> 18, n = o >> 7, dd = o & 127;
        GW[e] = (bf16)f2bf((g ? a.in[17] : a.in[15])[((size_t)((l * 2 + d) * 4 + n) * 128 + k) * 128 + dd]); }
    bf16* PW = (bf16*)(ws + WS_PW);
    for (int e = gt; e < DEPTH * 4 * 128 * 128; e += NGT) { const int k = e & 127, dd = (e >> 7) & 127, g = (e >> 14) & 3, l = e >> 16; PW[e] = (bf16)f2bf(a.in[20][((size_t)(l * 4 + g) * 128 + k) * 128 + dd]); }
    bf16* CKB = (bf16*)(ws + WS_CKB); bf16* CVB = (bf16*)(ws + WS_CVB);
    for (int e = gt; e < 2 * 4 * 512 * 256; e += NGT) { const int col = e & 255, rest = e >> 8, kvh = col >> 7, p = col & 127, j = p >> 1, s = p & 1, nat = (j >> 5) * 64 + s * 32 + (j & 31);
        CKB[e] = (bf16)f2bf(a.in[2][(size_t)rest * 256 + kvh * 128 + nat]); CVB[e] = (bf16)f2bf(a.in[3][e]); }
    float* rope = (float*)(ws + WS_ROPE);
    for (int e = gt; e < 2048; e += NGT) { const int p = e >> 5, i = e & 31; const float inv = __builtin_amdgcn_exp2f(-(float)i * 0.41524101186092029f); const float ang = (float)p * inv;
        double rev = (double)ang * 0.15915494309189535; rev -= (double)(long long)rev; const float rf = (float)rev;
        rope[e] = __builtin_amdgcn_cosf(rf); rope[2048 + e] = __builtin_amdgcn_sinf(rf); }
}
__device__ __forceinline__ void norm_phase(const float* xc, const float* xl, const float* gn, const float* modl, int sh_idx, int sc_idx, bf16* H, int gw, int NGW, int lane) {
    const int rpw = (MTOK + NGW - 1) / NGW; int ccur = -1; f32x4 ga[8], sh[8];
    for (int m = gw * rpw; m < (gw + 1) * rpw && m < MTOK; ++m) {
        const int cond = m < NCTX ? 0 : (m < NCTX + 2048 ? 1 : 2);
        if (cond != ccur) { ccur = cond; const float* sc = modl + cond * 12288 + sc_idx * 2048; const float* sf = modl + cond * 12288 + sh_idx * 2048;
#pragma unroll
            for (int j = 0; j < 8; ++j) { const f32x4 g = *(const f32x4*)(gn + 256 * j + 4 * lane), s = *(const f32x4*)(sc + 256 * j + 4 * lane); ga[j] = g * (1.0f + s); sh[j] = *(const f32x4*)(sf + 256 * j + 4 * lane); } }
        const float* xr = m < NCTX ? xc + (size_t)m * DM : xl + (size_t)(m - NCTX) * DM;
        f32x4 v[8]; float ss = 0.f;
#pragma unroll
        for (int j = 0; j < 8; ++j) { v[j] = *(const f32x4*)(xr + 256 * j + 4 * lane); ss += (v[j].x * v[j].x + v[j].y * v[j].y) + (v[j].z * v[j].z + v[j].w * v[j].w); }
        const float rstd = 1.0f / sqrtf(wave_sum(ss) * (1.0f / DM) + 1e-6f);
        unsigned long long* o8 = (unsigned long long*)(H + (size_t)m * DM) + lane;
#pragma unroll
        for (int j = 0; j < 8; ++j) { const f32x4 y = v[j] * rstd * ga[j] + sh[j]; o8[64 * j] = (unsigned long long)pk2(y.x, y.y) | ((unsigned long long)pk2(y.z, y.w) << 32); }
    }
}
__device__ __forceinline__ void final_norm_phase(const float* x, const float* gn, float* out, int gw, int NGW, int lane) {
    f32x4 ga[8];
#pragma unroll
    for (int j = 0; j < 8; ++j) ga[j] = *(const f32x4*)(gn + 256 * j + 4 * lane);
    for (int m = gw; m < MTOK; m += NGW) {
        const float* xr = x + (size_t)m * DM; f32x4 v[8]; float ss = 0.f;
#pragma unroll
        for (int j = 0; j < 8; ++j) { v[j] = *(const f32x4*)(xr + 256 * j + 4 * lane); ss += (v[j].x * v[j].x + v[j].y * v[j].y) + (v[j].z * v[j].z + v[j].w * v[j].w); }
        const float rstd = 1.0f / sqrtf(wave_sum(ss) * (1.0f / DM) + 1e-6f);
#pragma unroll
        for (int j = 0; j < 8; ++j) *(f32x4*)(out + (size_t)m * DM + 256 * j + 4 * lane) = v[j] * rstd * ga[j];
    }
}
struct SeqInfo { int T, seq, t0, seqrow0, nch, cc, chunk0; bool lat; };
__device__ __forceinline__ SeqInfo seq_info(int chunk) {
    SeqInfo s; const int r0 = chunk * 64;
    if (r0 < NCTX) { s.T = 256; s.seq = r0 >> 8; s.t0 = r0 & 255; s.seqrow0 = s.seq * 256; s.nch = 4; s.chunk0 = s.seq * 4; s.lat = false; }
    else { const int rr = r0 - NCTX; s.T = 2048; s.seq = rr >> 11; s.t0 = rr & 2047; s.seqrow0 = NCTX + s.seq * 2048; s.nch = 32; s.chunk0 = 128 + s.seq * 32; s.lat = true; }
    s.cc = s.t0 >> 6; return s;
}
constexpr int LU_UB = 0, LU_UF = 17408, LU_A = LU_UF + 33792, LU_B = LU_A + 33792, LU_END = LU_B + 33792;
static_assert(LU_END <= RING_BYTES, "LRU unit LDS");
__device__ __forceinline__ void lru_conv(const Args& a, LAS unsigned char* lds, int l, const SeqInfo& si, int nblk, int tid) {
    const bf16* P = (const bf16*)(a.ws + WS_P); LAS float* UF = (LAS float*)(lds + LU_UF);
    const int cg = tid & 15, tg = tid >> 4, c8 = cg * 8, cb = nblk * 128 + c8;
    float xw[5][8];
#pragma unroll
    for (int j = 0; j < 5; ++j) { const int tl = si.t0 + tg * 2 + j - 2;
        if (tl >= 0 && tl < si.T) { const bf16x8 v = *(const bf16x8*)(P + (size_t)(si.seqrow0 + tl) * DIN + 1536 + cb);
#pragma unroll
            for (int e = 0; e < 8; ++e) xw[j][e] = bf2f((unsigned short)v[e]); }
        else {
#pragma unroll
            for (int e = 0; e < 8; ++e) xw[j][e] = 0.f; } }
    float cw[4][8], cbias[8];
#pragma unroll
    for (int j = 0; j < 4; ++j) { const f32x4 w0 = *(const f32x4*)(a.in[13] + (size_t)(l * 4 + j) * 512 + cb), w1 = *(const f32x4*)(a.in[13] + (size_t)(l * 4 + j) * 512 + cb + 4);
        cw[j][0] = w0.x; cw[j][1] = w0.y; cw[j][2] = w0.z; cw[j][3] = w0.w; cw[j][4] = w1.x; cw[j][5] = w1.y; cw[j][6] = w1.z; cw[j][7] = w1.w; }
    { const f32x4 b0 = *(const f32x4*)(a.in[14] + l * 512 + cb), b1 = *(const f32x4*)(a.in[14] + l * 512 + cb + 4);
        cbias[0] = b0.x; cbias[1] = b0.y; cbias[2] = b0.z; cbias[3] = b0.w; cbias[4] = b1.x; cbias[5] = b1.y; cbias[6] = b1.z; cbias[7] = b1.w; }
#pragma unroll
    for (int q = 0; q < 2; ++q) { const int t = tg * 2 + q; float u[8];
#pragma unroll
        for (int e = 0; e < 8; ++e) u[e] = cbias[e] + cw[0][e] * xw[q][e] + cw[1][e] * xw[q + 1][e] + cw[2][e] * xw[q + 2][e] + cw[3][e] * xw[q + 3][e];
        *(LAS f32x4*)(UF + t * 132 + c8) = (f32x4){u[0], u[1], u[2], u[3]}; *(LAS f32x4*)(UF + t * 132 + c8 + 4) = (f32x4){u[4], u[5], u[6], u[7]};
        v4u w; w.x = pk2(u[0], u[1]); w.y = pk2(u[2], u[3]); w.z = pk2(u[4], u[5]); w.w = pk2(u[6], u[7]);
        *(LAS v4u*)(lds + LU_UB + t * 272 + c8 * 2) = w; }
}
__device__ __forceinline__ void lru_gates(const Args& a, LAS unsigned char* lds, int l, int nblk, int d, int lane, int wave) {
    const bf16* GW = (const bf16*)(a.ws + WS_GW);
    LAS float* UF = (LAS float*)(lds + LU_UF); LAS float* A_ = (LAS float*)(lds + LU_A); LAS float* B_ = (LAS float*)(lds + LU_B);
    const int q = lane >> 4, cl = lane & 15, ch = wave * 16 + cl, chg = nblk * 128 + ch;
    f32x4 acc[2][4];
#pragma unroll
    for (int g = 0; g < 2; ++g)
#pragma unroll
        for (int m = 0; m < 4; ++m) acc[g][m] = (f32x4){0.f, 0.f, 0.f, 0.f};
#pragma unroll
    for (int ks = 0; ks < 4; ++ks) {
        bf16x8 bw[2];
#pragma unroll
        for (int g = 0; g < 2; ++g) bw[g] = *(const bf16x8*)(GW + ((size_t)((l * 2 + d) * 2 + g) * 512 + chg) * 128 + ks * 32 + 8 * q);
#pragma unroll
        for (int m = 0; m < 4; ++m) { const bf16x8 au = *(const LAS bf16x8*)(lds + LU_UB + (m * 16 + cl) * 272 + (ks * 32 + 8 * q) * 2);
#pragma unroll
            for (int g = 0; g < 2; ++g) acc[g][m] = __builtin_amdgcn_mfma_f32_16x16x32_bf16(au, bw[g], acc[g][m], 0, 0, 0); }
    }
    const float bav = a.in[16][(l * 2 + d) * 512 + chg], bxv = a.in[18][(l * 2 + d) * 512 + chg], lamv = a.in[19][(l * 2 + d) * 512 + chg];
    const float ls8 = -8.0f * 1.4426950408889634f * log1pf(expf(-lamv));
#pragma unroll
    for (int m = 0; m < 4; ++m)
#pragma unroll
        for (int rg = 0; rg < 4; ++rg) { const int t = m * 16 + 4 * q + rg;
            const float r = sigmoidf_(acc[0][m][rg] + bav), ig = sigmoidf_(acc[1][m][rg] + bxv);
            const float l2 = ls8 * r, av = __builtin_amdgcn_exp2f(l2), x2 = 1.3862943611198906f * l2;
            const float om = x2 > -0.02f ? -x2 * (1.0f + 0.5f * x2 * (1.0f + x2 * 0.33333333f)) : 1.0f - av * av;
            const float bv = __builtin_amdgcn_sqrtf(om) * ig * UF[t * 132 + ch];
            A_[t * 132 + ch] = av; B_[t * 132 + ch] = bv; }
}
__device__ __forceinline__ void lru_out(const Args& a, const LAS float* Y, const LAS float* Y2, int r0, int nblk, int tid) {
    const bf16* P = (const bf16*)(a.ws + WS_P); bf16* mix = (bf16*)(a.ws + WS_MIX);
#pragma unroll
    for (int k = 0; k < 2; ++k) { const int i = tid + 512 * k, t = i >> 4, c8 = (i & 15) * 8;
        f32x4 y0 = *(const LAS f32x4*)(Y + t * 132 + c8), y1 = *(const LAS f32x4*)(Y + t * 132 + c8 + 4);
        if (Y2) { y0 += *(const LAS f32x4*)(Y2 + t * 132 + c8); y1 += *(const LAS f32x4*)(Y2 + t * 132 + c8 + 4); }
        const bf16x8 gv = *(const bf16x8*)(P + (size_t)(r0 + t) * DIN + 2048 + nblk * 128 + c8);
        float o[8];
#pragma unroll
        for (int e = 0; e < 8; ++e) { const float g = bf2f((unsigned short)gv[e]); const float z = 0.7978845608028654f * (g + 0.044715f * g * g * g); o[e] = (e < 4 ? y0[e] : y1[e - 4]) * g * sigmoidf_(2.0f * z); }
        v4u w; w.x = pk2(o[0], o[1]); w.y = pk2(o[2], o[3]); w.z = pk2(o[4], o[5]); w.w = pk2(o[6], o[7]);
        *(v4u*)(mix + (size_t)(r0 + t) * DM + 1024 + nblk * 128 + c8) = w; }
}
__device__ __forceinline__ void lru_lat_pass1(const Args& a, LAS unsigned char* lds, int l, int chunk, int nblk, int tid, int lane, int wave) {
    const SeqInfo si = seq_info(chunk); const int lrow0 = chunk * 64 - NCTX;
    float2* summ = (float2*)(a.ws + WS_SUMM); float* LAB = (float*)(a.ws + WS_LAB);
    LAS float* A_ = (LAS float*)(lds + LU_A); LAS float* B_ = (LAS float*)(lds + LU_B);
    lru_conv(a, lds, l, si, nblk, tid);
    __syncthreads();
#pragma unroll 1
    for (int d = 0; d < 2; ++d) {
        lru_gates(a, lds, l, nblk, d, lane, wave);
        __syncthreads();
        if (tid < 128) {
            float Ap = 1.f, Bp = 0.f;
#pragma unroll 16
            for (int i = 0; i < 64; ++i) { const int t = d ? 63 - i : i; const float av = A_[t * 132 + tid], bv = B_[t * 132 + tid]; Bp = av * Bp + bv; Ap *= av; }
            summ[(size_t)(chunk * 2 + d) * 512 + nblk * 128 + tid] = make_float2(Ap, Bp);
        }
        float* ga = LAB + ((size_t)(d * 2 + 0) * NLAT + lrow0) * 512 + nblk * 128; float* gb = LAB + ((size_t)(d * 2 + 1) * NLAT + lrow0) * 512 + nblk * 128;
#pragma unroll
        for (int k = 0; k < 4; ++k) { const int i = tid + 512 * k, t = i >> 5, c4 = (i & 31) * 4;
            *(f32x4*)(ga + (size_t)t * 512 + c4) = *(const LAS f32x4*)(A_ + t * 132 + c4); *(f32x4*)(gb + (size_t)t * 512 + c4) = *(const LAS f32x4*)(B_ + t * 132 + c4); }
        __syncthreads();
    }
}
__device__ __forceinline__ void lru_lat_pass2(const Args& a, LAS unsigned char* lds, int l, int chunk, int nblk, int tid) {
    const SeqInfo si = seq_info(chunk); const int r0 = chunk * 64, lrow0 = r0 - NCTX;
    const float2* summ = (const float2*)(a.ws + WS_SUMM); const float* LAB = (const float*)(a.ws + WS_LAB);
    LAS float* Y0 = (LAS float*)(lds + LU_A); LAS float* Y1 = (LAS float*)(lds + LU_B);
    if (tid < 256) {
        const int d = tid >> 7, c = tid & 127, c2 = nblk * 128 + c;
        float2 sv[32];
#pragma unroll
        for (int j = 0; j < 32; ++j) { const bool need = d == 0 ? (j < si.cc) : (j > si.cc); sv[j] = need ? summ[(size_t)((si.chunk0 + j) * 2 + d) * 512 + c2] : make_float2(1.f, 0.f); }
        float h = a.in[4][(size_t)((si.seq * 4 + l) * 2 + d) * 512 + c2];
        if (d == 0) {
#pragma unroll
            for (int j = 0; j < 32; ++j) h = sv[j].x * h + sv[j].y;
        } else {
#pragma unroll
            for (int j = 31; j >= 0; --j) h = sv[j].x * h + sv[j].y;
        }
        const float* ga = LAB + ((size_t)(d * 2 + 0) * NLAT + lrow0) * 512 + c2; const float* gb = LAB + ((size_t)(d * 2 + 1) * NLAT + lrow0) * 512 + c2;
        LAS float* Y = d ? Y1 : Y0;
#pragma unroll 1
        for (int i0 = 0; i0 < 64; i0 += 16) {
            float av[16], bv[16];
#pragma unroll
            for (int i = 0; i < 16; ++i) { const int t = d ? 63 - (i0 + i) : i0 + i; av[i] = ga[(size_t)t * 512]; bv[i] = gb[(size_t)t * 512]; }
#pragma unroll
            for (int i = 0; i < 16; ++i) { const int t = d ? 63 - (i0 + i) : i0 + i; h = av[i] * h + bv[i]; Y[t * 132 + c] = h; }
        }
    }
    __syncthreads();
    lru_out(a, Y0, Y1, r0, nblk, tid);
    __syncthreads();
}
__device__ __forceinline__ void lru_ctx_seq(const Args& a, LAS unsigned char* lds, int l, int seq, int nblk, int tid, int lane, int wave) {
    float* YF = (float*)(a.ws + WS_YF);
    LAS float* A_ = (LAS float*)(lds + LU_A); LAS float* B_ = (LAS float*)(lds + LU_B);
    const int c2 = nblk * 128 + tid;
    float h = 0.f;
#pragma unroll 1
    for (int cc = 0; cc < 4; ++cc) {
        const int chunk = seq * 4 + cc; const SeqInfo si = seq_info(chunk); const int r0 = chunk * 64;
        lru_conv(a, lds, l, si, nblk, tid);
        __syncthreads();
        lru_gates(a, lds, l, nblk, 0, lane, wave);
        __syncthreads();
        if (tid < 128) {
#pragma unroll 16
            for (int t = 0; t < 64; ++t) { h = A_[t * 132 + tid] * h + B_[t * 132 + tid]; YF[(size_t)(r0 + t) * 512 + c2] = h; }
        }
        __syncthreads();
    }
    if (tid < 128) a.out[O_ST + (size_t)((seq * 4 + l) * 2 + 0) * 512 + c2] = h;
    h = 0.f;
#pragma unroll 1
    for (int cc = 3; cc >= 0; --cc) {
        const int chunk = seq * 4 + cc; const SeqInfo si = seq_info(chunk); const int r0 = chunk * 64;
        lru_conv(a, lds, l, si, nblk, tid);
        __syncthreads();
        lru_gates(a, lds, l, nblk, 1, lane, wave);
        __syncthreads();
        if (tid < 128) {
#pragma unroll 1
            for (int i0 = 0; i0 < 64; i0 += 16) {
                float yf[16];
#pragma unroll
                for (int i = 0; i < 16; ++i) yf[i] = YF[(size_t)(r0 + 63 - (i0 + i)) * 512 + c2];
#pragma unroll
                for (int i = 0; i < 16; ++i) { const int t = 63 - (i0 + i); h = A_[t * 132 + tid] * h + B_[t * 132 + tid]; B_[t * 132 + tid] = yf[i] + h; }
            }
        }
        __syncthreads();
        lru_out(a, B_, nullptr, r0, nblk, tid);
        __syncthreads();
    }
    if (tid < 128) a.out[O_ST + (size_t)((seq * 4 + l) * 2 + 1) * 512 + c2] = h;
}
__device__ __forceinline__ void pool_unit(const Args& a, LAS unsigned char* lds, int l, int chunk, int g, int tid, int lane, int wave) {
    const SeqInfo si = seq_info(chunk); const int r0 = chunk * 64;
    const bf16* P = (const bf16*)(a.ws + WS_P); const bf16* PW = (const bf16*)(a.ws + WS_PW); bf16* mix = (bf16*)(a.ws + WS_MIX);
    {
        const int w2 = 1 << g, cg = tid & 15, tg = tid >> 4, c8 = cg * 8, colp = 2560 + g * 128 + c8;
#pragma unroll
        for (int qq = 0; qq < 2; ++qq) { const int t = tg * 2 + qq, tl = si.t0 + t; const int lo = tl - w2 > 0 ? tl - w2 : 0, hi = tl + w2 < si.T ? tl + w2 : si.T;
            float s[8];
#pragma unroll
            for (int e = 0; e < 8; ++e) s[e] = 0.f;
            for (int r = lo; r < hi; ++r) { const bf16x8 v = *(const bf16x8*)(P + (size_t)(si.seqrow0 + r) * DIN + colp);
#pragma unroll
                for (int e = 0; e < 8; ++e) s[e] += bf2f((unsigned short)v[e]); }
            const bf16x8 sv = *(const bf16x8*)(P + (size_t)(si.seqrow0 + tl) * DIN + colp); const float inv = 1.0f / (float)(hi - lo);
            float pz[8];
#pragma unroll
            for (int e = 0; e < 8; ++e) pz[e] = s[e] * inv - bf2f((unsigned short)sv[e]);
            v4u w; w.x = pk2(pz[0], pz[1]); w.y = pk2(pz[2], pz[3]); w.z = pk2(pz[4], pz[5]); w.w = pk2(pz[6], pz[7]);
            *(LAS v4u*)(lds + LU_UB + t * 272 + c8 * 2) = w; }
    }
    __syncthreads();
    const int q = lane >> 4, cl = lane & 15, dch = wave * 16 + cl;
    f32x4 acc[4];
#pragma unroll
    for (int m = 0; m < 4; ++m) acc[m] = (f32x4){0.f, 0.f, 0.f, 0.f};
#pragma unroll
    for (int ks = 0; ks < 4; ++ks) { const bf16x8 bw = *(const bf16x8*)(PW + ((size_t)(l * 4 + g) * 128 + dch) * 128 + ks * 32 + 8 * q);
#pragma unroll
        for (int m = 0; m < 4; ++m) { const bf16x8 au = *(const LAS bf16x8*)(lds + LU_UB + (m * 16 + cl) * 272 + (ks * 32 + 8 * q) * 2); acc[m] = __builtin_amdgcn_mfma_f32_16x16x32_bf16(au, bw, acc[m], 0, 0, 0); } }
    const float sc = a.in[21][l * 512 + g * 128 + dch];
#pragma unroll
    for (int m = 0; m < 4; ++m)
#pragma unroll
        for (int rg = 0; rg < 4; ++rg) { const int t = m * 16 + 4 * q + rg; mix[(size_t)(r0 + t) * DM + 1536 + g * 128 + dch] = (bf16)f2bf(acc[m][rg] * sc); }
    __syncthreads();
}
__device__ __forceinline__ void attn_ctx_unit(const Args& a, char* lds, int l, int i) {
    const int b = i >> 3, h = i & 7, kvh = h >> 2;
    const bf16* P = (const bf16*)(a.ws + WS_P); bf16* mix = (bf16*)(a.ws + WS_MIX);
    att::Src S; S.k0 = P + (size_t)(b * 256) * DIN + 1024 + kvh * 128; S.v0 = S.k0 + 256; S.ld0 = DIN; S.n0 = 4; S.k1 = S.k0; S.v1 = S.v0; S.ld1 = DIN; S.nt = 4; S.jb_lo = 0;
    att::attn_unit<false>(P + (size_t)(b * 256) * DIN + h * 128, DIN, S, a.in[12][l * 8 + h], mix + (size_t)(b * 256) * DM + h * 128, DM, lds);
}
__device__ __forceinline__ void attn_lat_unit(const Args& a, char* lds, int l, int i) {
    const int b = i >> 6, h = (i >> 3) & 7, qb = i & 7, kvh = h >> 2, q0 = qb * 256, rowbase = NCTX + b * 2048;
    const bf16* P = (const bf16*)(a.ws + WS_P); bf16* mix = (bf16*)(a.ws + WS_MIX);
    const bf16* CKB = (const bf16*)(a.ws + WS_CKB); const bf16* CVB = (const bf16*)(a.ws + WS_CVB);
    const int jb_lo = qb == 0 ? 2 : 0, jb_hi = qb == 7 ? 6 : 8;
    att::Src S; S.k0 = CKB + (size_t)((b * 4 + l) * 512) * 256 + kvh * 128; S.v0 = CVB + (size_t)((b * 4 + l) * 512) * 256 + kvh * 128; S.ld0 = 256; S.n0 = 8;
    S.k1 = P + (size_t)(rowbase + q0 - 128 + jb_lo * 64) * DIN + 1024 + kvh * 128; S.v1 = S.k1 + 256; S.ld1 = DIN; S.nt = 8 + jb_hi - jb_lo; S.jb_lo = jb_lo;
    att::attn_unit<true>(P + (size_t)(rowbase + q0) * DIN + h * 128, DIN, S, a.in[12][l * 8 + h], mix + (size_t)(rowbase + q0) * DM + h * 128, DM, lds);
}
constexpr int N_PHASES = 2 + 8 * DEPTH + 1;
#ifndef REP_PRO
#define REP_PRO 1
#endif
#ifndef REP_NORM
#define REP_NORM 1
#endif
#ifndef REP_G1
#define REP_G1 1
#endif
#ifndef REP_L1
#define REP_L1 1
#endif
#ifndef REP_ATT
#define REP_ATT 1
#endif
#ifndef REP_CSEQ
#define REP_CSEQ 1
#endif
#ifndef TAIL_FILL
#define TAIL_FILL 1
#endif
#ifndef REP_FILL
#define REP_FILL 1
#endif
#ifndef REP_L2
#define REP_L2 1
#endif
#ifndef REP_POOL
#define REP_POOL 1
#endif
#ifndef REP_G2
#define REP_G2 1
#endif
#ifndef REP_G3
#define REP_G3 1
#endif
#ifndef REP_G4
#define REP_G4 1
#endif
constexpr int CV_A = 3000, CV_B = 5800;
#define REPEAT(n) _Pragma("unroll 1") for (int rep_ = 0; rep_ < (n); ++rep_)
#define DUMMY ((float*)(ws + WS_END))
__device__ __forceinline__ int lista_index(int w, int s, int G) { const int i = w + s * G; return i < 256 ? i : -1; }
#if defined(__HIP_DEVICE_COMPILE__)
#define PHASE_ARGS const __attribute__((address_space(4))) Args* ap_ = (const __attribute__((address_space(4))) Args*)__builtin_amdgcn_kernarg_segment_ptr(); asm volatile("" : "+s"(ap_)); const Args a = *ap_;
#else
#define PHASE_ARGS const Args a = a_;
#endif
#define PHASE_LOCALS int tid = threadIdx.x; asm volatile("" : "+v"(tid)); const int lane = tid & 63, wave = __builtin_amdgcn_readfirstlane(tid >> 6); PHASE_ARGS \
    unsigned char* ws = a.ws; const int G = gridDim.x; const int gw = blockIdx.x * NWAVES + wave, NGW = G * NWAVES; (void)lane; (void)gw; (void)NGW; (void)ws;
__global__ void __launch_bounds__(NWAVES * 64, 2) fwd_kernel(Args a_) {
    extern __shared__ __attribute__((aligned(16))) unsigned char lds_raw[];
    LAS unsigned char* lds = (LAS unsigned char*)lds_raw;
    for (int u = threadIdx.x; u < (LDS_BYTES - LDSCTL_OFF) / 4; u += NWAVES * 64) ((LAS unsigned*)(lds + LDSCTL_OFF))[u] = 0u;
    __syncthreads();
#if !MK_PER_PHASE
    XcdBarrier bar = xcd_barrier_post((unsigned*)(a_.ws + WS_CTL) + CW_BAR, (volatile LAS unsigned*)(lds + MISC_OFF) + 8);
#define SEAM(k) do { if ((k) + 1 < hi) xcd_barrier(bar); } while (0)
#else
#define SEAM(k) do { } while (0)
#endif
    const int lo = a_.ph_lo, hi = a_.ph_hi;
#define IN(k) (lo <= (k) && (k) < hi)
#define XBUF ((float*)(ws + WS_X))
#define HB ((bf16*)(ws + WS_H))
#define PB ((bf16*)(ws + WS_P))
#define MIXB ((bf16*)(ws + WS_MIX))
#define ACTB ((bf16*)(ws + WS_ACT))
#define MODL ((const float*)(ws + WS_MODV) + (size_t)l * 3 * 12288)
#define ROPE ((const float*)(ws + WS_ROPE))
#define XC (l == 0 ? a.in[0] : (const float*)XBUF)
#define XL (l == 0 ? a.in[1] : (const float*)XBUF + (size_t)NCTX * DM)

#ifndef NO_PRO
    if (IN(0)) { REPEAT(REP_PRO) { PHASE_LOCALS p0_prologue(a, lds, tid, lane, wave, G); __syncthreads();
        if (!TAIL_FILL) { for (int l2 = 1; l2 < DEPTH; ++l2) { mod_partials(a, lds, l2, (int)blockIdx.x, G, tid); convert_layer_weights(a, lds, l2, 0, IT_LAYER, (int)blockIdx.x * NWAVES + wave, G * NWAVES, lane, wave); } } } SEAM(0); }
    if (IN(1)) { { PHASE_LOCALS mod_reduce(a, 0, (int)blockIdx.x * 512 + tid, G * 512); if (!TAIL_FILL) { for (int l2 = 1; l2 < DEPTH; ++l2) mod_reduce(a, l2, (int)blockIdx.x * 512 + tid, G * 512); } } SEAM(1); }
#endif
    for (int l = 0; l < DEPTH; ++l) {
        const int pb = 2 + 8 * l;
#ifndef NO_NORM
        if (IN(pb + 0)) { REPEAT(REP_NORM) { PHASE_LOCALS norm_phase(XC, XL, a.in[9] + l * DM, MODL, 0, 1, HB, gw, NGW, lane); } SEAM(pb + 0); }
#endif
#ifndef NO_G1
        if (IN(pb + 1)) {
            REPEAT(REP_G1) { PHASE_LOCALS
            pg8::Gemm g{HB, (const bf16*)(ws + WS_WIN + l * SZ_WIN), MTOK, DIN, DM}; pg8::StaticOrder S; S.init(MTOK, DIN, G, (int)blockIdx.x);
            pg8::EpiIn E{PB, a.out + O_CK, a.out + O_CV, ROPE, ROPE + 2048, l};
            pg8::gemm_phase<pg8::EpiIn, pg8::StaticOrder, true, true>(lds + RING_OFF, g, S, E); }
            if (TAIL_FILL && l + 1 < DEPTH) { PHASE_LOCALS
                const int rem = (MTOK / 256) * (DIN / 256) % G, first = rem ? rem : 0;
                if ((int)blockIdx.x >= first) REPEAT(REP_FILL) convert_layer_weights(a, lds, l + 1, 0, CV_A, ((int)blockIdx.x - first) * NWAVES + wave, (G - first) * NWAVES, lane, wave); }
            SEAM(pb + 1);
        }
#endif
#ifndef NO_LRU1
        if (IN(pb + 2)) { REPEAT(REP_L1) { PHASE_LOCALS for (int u = blockIdx.x; u < 256; u += G) lru_lat_pass1(a, lds, l, 128 + (u >> 2), u & 3, tid, lane, wave); } SEAM(pb + 2); }
#endif
        if (IN(pb + 3)) {
#ifndef NO_ATT
            REPEAT(REP_ATT) { PHASE_LOCALS
            for (int s = 0;; ++s) { const int i = lista_index((int)blockIdx.x, s, G); if (i < 0) break; if (i < 128) attn_lat_unit(a, (char*)lds_raw, l, i); }
            for (int i = blockIdx.x; i < 256; i += G) attn_ctx_unit(a, (char*)lds_raw, l, i); }
            __syncthreads();
            REPEAT(REP_CSEQ) { PHASE_LOCALS
            for (int s = 0;; ++s) { const int i = lista_index((int)blockIdx.x, s, G); if (i < 0) break; if (i >= 128) lru_ctx_seq(a, lds, l, (i - 128) >> 2, (i - 128) & 3, tid, lane, wave); } }
#endif
            __syncthreads();
#ifndef NO_LRU2
            REPEAT(REP_L2) { PHASE_LOCALS for (int u = blockIdx.x; u < 256; u += G) lru_lat_pass2(a, lds, l, 128 + (u >> 2), u & 3, tid); }
#endif
#ifndef NO_POOL
            REPEAT(REP_POOL) { PHASE_LOCALS
                for (int s = 0;; ++s) { int u; if (G == 256) { const int w = blockIdx.x; u = w < 128 ? (s < 5 ? w * 5 + s : -1) : (s < 1 ? 640 + (w - 128) : -1); } else { u = blockIdx.x + s * G; if (u >= 768) u = -1; }
                    if (u < 0) break; pool_unit(a, lds, l, u >> 2, u & 3, tid, lane, wave); } }
#endif
            SEAM(pb + 3);
        }
#ifndef NO_G2
        if (IN(pb + 4)) {
            REPEAT(REP_G2) { PHASE_LOCALS
            pg8::Gemm g{MIXB, (const bf16*)(ws + WS_WOUT + l * SZ_WOUT), MTOK, DM, DM}; pg8::StaticOrder S; S.init(MTOK, DM, G, (int)blockIdx.x);
            pg8::EpiRes E{XC, XL, rep_ ? DUMMY : XBUF, MODL + 2 * 2048};
            pg8::gemm_phase<pg8::EpiRes, pg8::StaticOrder, true, true>(lds + RING_OFF, g, S, E); }
            if (TAIL_FILL && l + 1 < DEPTH) { PHASE_LOCALS
                const int rem = (MTOK / 256) * (DM / 256) % G, first = rem ? rem : 0;
                if ((int)blockIdx.x >= first) REPEAT(REP_FILL) mod_partials(a, lds, l + 1, (int)blockIdx.x - first, G - first, tid); }
            SEAM(pb + 4);
        }
#endif
#ifndef NO_NORM
        if (IN(pb + 5)) { REPEAT(REP_NORM) { PHASE_LOCALS norm_phase(XBUF, XBUF + (size_t)NCTX * DM, a.in[10] + l * DM, MODL, 3, 4, HB, gw, NGW, lane); } SEAM(pb + 5); }
#endif
#ifndef NO_G3
        if (IN(pb + 6)) {
            REPEAT(REP_G3) { PHASE_LOCALS
            pg8::Gemm g{HB, (const bf16*)(ws + WS_W1 + l * SZ_W1), MTOK, 2 * DFF, DM}; pg8::StaticOrder S; S.init(MTOK, 2 * DFF, G, (int)blockIdx.x);
            pg8::EpiSwiGLU E{ACTB};
            pg8::gemm_phase<pg8::EpiSwiGLU, pg8::StaticOrder, true, true>(lds + RING_OFF, g, S, E); }
            if (TAIL_FILL && l + 1 < DEPTH) { PHASE_LOCALS
                const int rem = (MTOK / 256) * (2 * DFF / 256) % G, first = rem ? rem : 0;
                if ((int)blockIdx.x >= first) REPEAT(REP_FILL) convert_layer_weights(a, lds, l + 1, CV_A, CV_B, ((int)blockIdx.x - first) * NWAVES + wave, (G - first) * NWAVES, lane, wave); }
            SEAM(pb + 6);
        }
#endif
#ifndef NO_G4
        if (IN(pb + 7)) {
            REPEAT(REP_G4) { PHASE_LOCALS
            pg8::Gemm g{ACTB, (const bf16*)(ws + WS_W2 + l * SZ_W2), MTOK, DM, DFF}; pg8::StaticOrder S; S.init(MTOK, DM, G, (int)blockIdx.x);
            pg8::EpiRes E{XBUF, XBUF + (size_t)NCTX * DM, rep_ ? DUMMY : XBUF, MODL + 5 * 2048};
            pg8::gemm_phase<pg8::EpiRes, pg8::StaticOrder, true, true>(lds + RING_OFF, g, S, E); }
            if (TAIL_FILL && l + 1 < DEPTH) { PHASE_LOCALS
                const int rem = (MTOK / 256) * (DM / 256) % G, first = rem ? rem : 0;
                if ((int)blockIdx.x >= first) { const int rk = (int)blockIdx.x - first, nr = G - first;
                    mod_reduce(a, l + 1, rk * 512 + tid, nr * 512);
                    REPEAT(REP_FILL) convert_layer_weights(a, lds, l + 1, CV_B, IT_LAYER, rk * NWAVES + wave, nr * NWAVES, lane, wave); } }
            SEAM(pb + 7);
        }
#endif
    }
    if (IN(N_PHASES - 1)) { PHASE_LOCALS final_norm_phase(XBUF, a.in[25], a.out + O_YP, gw, NGW, lane); }
#undef IN
#undef SEAM
}

extern "C" void kernel_launch(void* const* d_in, const int* in_sizes, int n_in, void* d_out, int out_size, void* d_ws, size_t ws_size, hipStream_t stream) {
    static int grid = 0;
    if (grid == 0) {
        if (n_in != 26 || (size_t)out_size != O_END || ws_size < WS_END + (size_t)MTOK * DM * 4) { fprintf(stderr, "kernel_launch: built for 26 inputs, %zu outputs, >= %zu bytes of workspace; got n_in %d, out %d, ws %zu; nothing launched\n", (size_t)O_END, (size_t)WS_END, n_in, out_size, ws_size); grid = -1; return; }
        int dev = 0, cus = 0, per_cu = 0;
        if (hipGetDevice(&dev) != hipSuccess || hipDeviceGetAttribute(&cus, hipDeviceAttributeMultiprocessorCount, dev) != hipSuccess) { fprintf(stderr, "kernel_launch: device query failed\n"); grid = -1; return; }
        if (hipFuncSetAttribute((const void*)fwd_kernel, hipFuncAttributeMaxDynamicSharedMemorySize, LDS_BYTES) != hipSuccess) { fprintf(stderr, "kernel_launch: hipFuncSetAttribute failed\n"); grid = -1; return; }
        if (hipOccupancyMaxActiveBlocksPerMultiprocessor(&per_cu, (const void*)fwd_kernel, NWAVES * 64, LDS_BYTES) != hipSuccess || per_cu < 1)
            fprintf(stderr, "kernel_launch: note: occupancy query reports %d workgroups per CU\n", per_cu);
        (void)hipGetLastError();
        grid = cus;
    }
    if (grid < 0) return;
    if (hipMemsetAsync((char*)d_ws + WS_CTL, 0, CTL_ZERO_BYTES, stream) != hipSuccess) { fprintf(stderr, "kernel_launch: memset failed\n"); return; }
    Args a{};
    for (int i = 0; i < 26; ++i) a.in[i] = (const float*)d_in[i];
    a.out = (float*)d_out; a.ws = (unsigned char*)d_ws;
#if MK_PER_PHASE
    for (int p = 0; p < N_PHASES; ++p) { a.ph_lo = p; a.ph_hi = p + 1; hipLaunchKernelGGL(fwd_kernel, dim3(grid), dim3(NWAVES * 64), LDS_BYTES, stream, a); }
#else
    a.ph_lo = 0; a.ph_hi = N_PHASES; hipLaunchKernelGGL(fwd_kernel, dim3(grid), dim3(NWAVES * 64), LDS_BYTES, stream, a);
#endif
    const hipError_t le = hipPeekAtLastError();
    if (le != hipSuccess) fprintf(stderr, "kernel_launch: launch failed: %s\n", hipGetErrorName(le));
}
```
